# Optimizing an MI355X kernel written in HIP

```python
import math
import jax, jax.numpy as jnp
from jax import lax
import numpy as np

D_MODEL = 1024
BATCH = 2
SEQ = 8192
DEPTH = 2

D_MIX = D_MODEL
HEAD_DIM = 64
CONV_CH = D_MODEL // 4
MOBA_HEADS = (3 * D_MODEL // 8) // HEAD_DIM
MOBA_W = MOBA_HEADS * HEAD_DIM
GDN_W = D_MIX - CONV_CH - MOBA_W
GDN_HEADS = GDN_W // HEAD_DIM
CONV_K = 31
MOBA_BLOCK = 256
MOBA_TOPK = 3
Q_BLOCK = 64
ROPE_THETA = 500000.0
ROPE_DIM = HEAD_DIM // 4
GDN_CONV_K = 4
GDN_CHUNK = 64
D_FF = ((8 * D_MODEL // 3 + 255) // 256) * 256
N_MOD = 9
EPS = 1e-6
IN_CONV = 2 * CONV_CH
IN_MOBA = 3 * MOBA_W
IN_GDN = 4 * GDN_W + 2 * GDN_HEADS
D_IN = IN_CONV + IN_MOBA + IN_GDN

kernel_name = "hymba_conformer_moba_gdn_trunk"

F32 = jnp.float32


def rmsnorm(x, g):
    xf = x.astype(F32)
    y = xf * lax.rsqrt(jnp.mean(xf * xf, axis=-1, keepdims=True) + EPS)
    return (y * g.astype(F32)).astype(x.dtype)


def modulate(x, g, shift, scale):
    return rmsnorm(x, g) * (1 + scale[:, None, :]) + shift[:, None, :]


def swiglu(h, w_gate, w_up, w_down):
    return (jax.nn.silu(h @ w_gate) * (h @ w_up)) @ w_down


def causal_depthwise_conv(x, w):
    K, C = w.shape
    xp = jnp.pad(x, ((0, 0), (K - 1, 0), (0, 0)))
    return lax.conv_general_dilated(xp, w[:, None, :].astype(x.dtype), window_strides=(1,), padding='VALID',
                                    dimension_numbers=('NWC', 'WIO', 'NWC'), feature_group_count=C)


def conformer_conv(u, w_dw, b_dw, ln_g, ln_b):
    a, gate = jnp.split(u, 2, axis=-1)
    h = a * jax.nn.sigmoid(gate)
    h = (causal_depthwise_conv(h, w_dw) + b_dw).astype(F32)
    mu = jnp.mean(h, axis=-1, keepdims=True)
    var = jnp.mean(jnp.square(h - mu), axis=-1, keepdims=True)
    h = (h - mu) * lax.rsqrt(var + EPS) * ln_g.astype(F32) + ln_b.astype(F32)
    return jax.nn.silu(h).astype(u.dtype)


def partial_rope(x, pos):
    half = ROPE_DIM // 2
    inv = jnp.exp(-math.log(ROPE_THETA) * jnp.arange(0, ROPE_DIM, 2, dtype=F32) / ROPE_DIM)
    ang = pos.astype(F32)[:, None] * inv[None, :]
    cos = jnp.cos(ang)[None, :, None, :]
    sin = jnp.sin(ang)[None, :, None, :]
    xr = x[..., :ROPE_DIM].astype(F32)
    x1, x2 = xr[..., :half], xr[..., half:]
    rot = jnp.concatenate([x1 * cos - x2 * sin, x2 * cos + x1 * sin], axis=-1)
    return jnp.concatenate([rot.astype(x.dtype), x[..., ROPE_DIM:]], axis=-1)


def moba_attention(q, k, v):
    B, S, H, dh = q.shape
    nb = -(-S // MOBA_BLOCK)
    s_pad = nb * MOBA_BLOCK
    q = q.transpose(0, 2, 1, 3)
    pad = ((0, 0), (0, 0), (0, s_pad - S), (0, 0))
    kb = jnp.pad(k.transpose(0, 2, 1, 3), pad).reshape(B, H, nb, MOBA_BLOCK, dh)
    vb = jnp.pad(v.transpose(0, 2, 1, 3), pad).reshape(B, H, nb, MOBA_BLOCK, dh)
    k_mean = jnp.mean(kb.astype(F32), axis=3)
    gate_s = jnp.einsum('bhsd,bhnd->bhsn', q.astype(F32), k_mean)
    q_blk = jnp.arange(S) // MOBA_BLOCK
    past = jnp.arange(nb)[None, :] < q_blk[:, None]
    gate_s = jnp.where(past, gate_s, -jnp.inf)
    topk = min(MOBA_TOPK, nb)
    _, sel = lax.top_k(gate_s, topk)
    sel_valid = sel < q_blk[:, None]
    scale = dh ** -0.5
    bidx = jnp.arange(B)[:, None, None, None]
    hidx = jnp.arange(H)[None, :, None, None]

    def one_block(i):
        start = i * Q_BLOCK
        qi = lax.dynamic_slice_in_dim(q, start, Q_BLOCK, axis=2)
        seli = lax.dynamic_slice_in_dim(sel, start, Q_BLOCK, axis=2)
        vali = lax.dynamic_slice_in_dim(sel_valid, start, Q_BLOCK, axis=2)
        ksel = kb[bidx, hidx, seli]
        vsel = vb[bidx, hidx, seli]
        own = start // MOBA_BLOCK
        kown = lax.dynamic_index_in_dim(kb, own, axis=2, keepdims=False)
        vown = lax.dynamic_index_in_dim(vb, own, axis=2, keepdims=False)
        s_sel = jnp.einsum('bhqd,bhqnkd->bhqnk', qi, ksel, preferred_element_type=F32) * scale
        s_sel = jnp.where(vali[..., None], s_sel, -jnp.inf).reshape(B, H, Q_BLOCK, topk * MOBA_BLOCK)
        s_own = jnp.einsum('bhqd,bhkd->bhqk', qi, kown, preferred_element_type=F32) * scale
        qpos = start + jnp.arange(Q_BLOCK)
        kpos = own * MOBA_BLOCK + jnp.arange(MOBA_BLOCK)
        s_own = jnp.where(kpos[None, :] <= qpos[:, None], s_own, -jnp.inf)
        p = jax.nn.softmax(jnp.concatenate([s_sel, s_own], axis=-1), axis=-1)
        p_sel = p[..., :topk * MOBA_BLOCK].reshape(B, H, Q_BLOCK, topk, MOBA_BLOCK)
        p_own = p[..., topk * MOBA_BLOCK:]
        o = (jnp.einsum('bhqnk,bhqnkd->bhqd', p_sel, vsel.astype(F32))
             + jnp.einsum('bhqk,bhkd->bhqd', p_own, vown.astype(F32)))
        return o.astype(q.dtype)

    out = lax.map(one_block, jnp.arange(S // Q_BLOCK))
    return out.transpose(1, 0, 3, 2, 4).reshape(B, S, H * dh)


def l2norm(x):
    return x * lax.rsqrt(jnp.sum(x * x, axis=-1, keepdims=True) + EPS)


def gated_delta_net(q, k, v, g, beta):
    B, S, H, dk = q.shape
    dv = v.shape[-1]
    C = GDN_CHUNK
    N = S // C
    q = q * dk ** -0.5
    tr = lambda t: t.transpose(0, 2, 1, 3).reshape(B, H, N, C, t.shape[-1])
    q, k, v = tr(q), tr(k), tr(v)
    g = jnp.cumsum(g.transpose(0, 2, 1).reshape(B, H, N, C), axis=-1)
    beta = beta.transpose(0, 2, 1).reshape(B, H, N, C)
    k_beta = k * beta[..., None]
    v_beta = v * beta[..., None]
    tril = jnp.tril(jnp.ones((C, C), dtype=bool))
    strict = jnp.tril(jnp.ones((C, C), dtype=bool), -1)
    decay = jnp.exp(jnp.where(tril, g[..., :, None] - g[..., None, :], -jnp.inf))
    L = jnp.where(strict, jnp.einsum('bhncd,bhnsd->bhncs', k_beta, k) * decay, 0.0)
    eye = jnp.eye(C, dtype=F32)
    T = lax.linalg.triangular_solve(eye + L, jnp.broadcast_to(eye, L.shape), left_side=True, lower=True)
    u = T @ v_beta
    w = T @ (k_beta * jnp.exp(g)[..., None])
    qk = jnp.where(tril, jnp.einsum('bhncd,bhnsd->bhncs', q, k) * decay, 0.0)
    g_last = g[..., -1]
    k_dec = k * jnp.exp(g_last[..., None] - g)[..., None]
    q_dec = q * jnp.exp(g)[..., None]

    def step(state, xs):
        q_i, qk_i, k_i, u_i, w_i, gl_i = xs
        v_new = u_i - w_i @ state
        o = q_i @ state + qk_i @ v_new
        state = state * jnp.exp(gl_i)[..., None, None] + jnp.swapaxes(k_i, -1, -2) @ v_new
        return state, o

    mv = lambda t: jnp.moveaxis(t, 2, 0)
    xs = (mv(q_dec), mv(qk), mv(k_dec), mv(u), mv(w), mv(g_last))
    state0 = jnp.zeros((B, H, dk, dv), F32)
    _, o = lax.scan(step, state0, xs)
    return o.transpose(1, 0, 3, 2, 4).reshape(B, S, H, dv)


def token_mixing(h, w_in, conv_w, conv_b, conv_ln_g, conv_ln_b, gdn_conv_w, gdn_a_log, gdn_dt_bias, gdn_norm_g, w_out):
    B, S, _ = h.shape
    u = h @ w_in
    u_conv, u_moba, u_gdn = jnp.split(u, [IN_CONV, IN_CONV + IN_MOBA], axis=-1)
    y_conv = conformer_conv(u_conv, conv_w, conv_b, conv_ln_g, conv_ln_b)
    mq, mk, mv = [t.reshape(B, S, MOBA_HEADS, HEAD_DIM) for t in jnp.split(u_moba, 3, axis=-1)]
    pos = jnp.arange(S)
    y_moba = moba_attention(partial_rope(mq, pos), partial_rope(mk, pos), mv)
    qkv = u_gdn[..., :3 * GDN_W]
    z = u_gdn[..., 3 * GDN_W:4 * GDN_W].reshape(B, S, GDN_HEADS, HEAD_DIM).astype(F32)
    a = u_gdn[..., 4 * GDN_W:4 * GDN_W + GDN_HEADS].astype(F32)
    b = u_gdn[..., 4 * GDN_W + GDN_HEADS:].astype(F32)
    qkv = jax.nn.silu(causal_depthwise_conv(qkv, gdn_conv_w)).astype(F32)
    gq, gk, gv = [t.reshape(B, S, GDN_HEADS, HEAD_DIM) for t in jnp.split(qkv, 3, axis=-1)]
    beta = jax.nn.sigmoid(b)
    g = -jnp.exp(gdn_a_log.astype(F32)) * jax.nn.softplus(a + gdn_dt_bias.astype(F32))
    o = gated_delta_net(l2norm(gq), l2norm(gk), gv, g, beta)
    o = rmsnorm(o, gdn_norm_g) * jax.nn.silu(z)
    y_gdn = o.reshape(B, S, GDN_W).astype(h.dtype)
    y = jnp.concatenate([y_conv, y_moba, y_gdn], axis=-1)
    return y @ w_out


def setup_inputs(seed: int = 0) -> dict:
    key = jax.random.key(seed)
    ks = jax.random.split(key, 24)
    nrm = lambda k, shape, s: jax.random.normal(k, shape, F32) * s
    gain = lambda k, shape: 1.0 + 0.02 * jax.random.normal(k, shape, F32)
    dt = jnp.exp(jax.random.uniform(ks[16], (DEPTH, GDN_HEADS), F32) * (math.log(0.1) - math.log(0.001)) + math.log(0.001))
    return {
        "x": jax.random.normal(ks[0], (BATCH, SEQ, D_MODEL), F32),
        "c": jax.random.normal(ks[1], (BATCH, D_MODEL), F32),
        "w_ada": nrm(ks[2], (DEPTH, D_MODEL, N_MOD * D_MODEL), 0.5 * D_MODEL ** -0.5),
        "b_ada": nrm(ks[3], (DEPTH, N_MOD * D_MODEL), 0.02),
        "ln_ffn1_g": gain(ks[4], (DEPTH, D_MODEL)),
        "ffn1_w_gate": nrm(ks[5], (DEPTH, D_MODEL, D_FF), D_MODEL ** -0.5),
        "ffn1_w_up": nrm(ks[6], (DEPTH, D_MODEL, D_FF), D_MODEL ** -0.5),
        "ffn1_w_down": nrm(ks[7], (DEPTH, D_FF, D_MODEL), D_FF ** -0.5),
        "ln_mix_g": gain(ks[8], (DEPTH, D_MODEL)),
        "w_in": nrm(ks[9], (DEPTH, D_MODEL, D_IN), D_MODEL ** -0.5),
        "conv_w": nrm(ks[10], (DEPTH, CONV_K, CONV_CH), CONV_K ** -0.5),
        "conv_b": nrm(ks[11], (DEPTH, CONV_CH), 0.02),
        "conv_ln_g": gain(ks[12], (DEPTH, CONV_CH)),
        "conv_ln_b": nrm(ks[13], (DEPTH, CONV_CH), 0.02),
        "gdn_conv_w": nrm(ks[14], (DEPTH, GDN_CONV_K, 3 * GDN_W), GDN_CONV_K ** -0.5),
        "gdn_a_log": jnp.log(jax.random.uniform(ks[15], (DEPTH, GDN_HEADS), F32, 1.0, 16.0)),
        "gdn_dt_bias": dt + jnp.log(-jnp.expm1(-dt)),
        "gdn_norm_g": gain(ks[17], (DEPTH, HEAD_DIM)),
        "w_out": nrm(ks[18], (DEPTH, D_MIX, D_MODEL), D_MIX ** -0.5),
        "ln_ffn2_g": gain(ks[19], (DEPTH, D_MODEL)),
        "ffn2_w_gate": nrm(ks[20], (DEPTH, D_MODEL, D_FF), D_MODEL ** -0.5),
        "ffn2_w_up": nrm(ks[21], (DEPTH, D_MODEL, D_FF), D_MODEL ** -0.5),
        "ffn2_w_down": nrm(ks[22], (DEPTH, D_FF, D_MODEL), D_FF ** -0.5),
        "final_g": gain(ks[23], (D_MODEL,)),
    }


def reference(x, c, w_ada, b_ada, ln_ffn1_g, ffn1_w_gate, ffn1_w_up, ffn1_w_down, ln_mix_g, w_in, conv_w, conv_b,
              conv_ln_g, conv_ln_b, gdn_conv_w, gdn_a_log, gdn_dt_bias, gdn_norm_g, w_out, ln_ffn2_g,
              ffn2_w_gate, ffn2_w_up, ffn2_w_down, final_g):
    c_act = jax.nn.silu(c)
    for l in range(DEPTH):
        mod = c_act @ w_ada[l] + b_ada[l]
        sh1, sc1, gt1, sh2, sc2, gt2, sh3, sc3, gt3 = jnp.split(mod, N_MOD, axis=-1)
        h = modulate(x, ln_ffn1_g[l], sh1, sc1)
        x = x + 0.5 * gt1[:, None, :] * swiglu(h, ffn1_w_gate[l], ffn1_w_up[l], ffn1_w_down[l])
        h = modulate(x, ln_mix_g[l], sh2, sc2)
        x = x + gt2[:, None, :] * token_mixing(h, w_in[l], conv_w[l], conv_b[l], conv_ln_g[l], conv_ln_b[l],
                                                gdn_conv_w[l], gdn_a_log[l], gdn_dt_bias[l], gdn_norm_g[l], w_out[l])
        h = modulate(x, ln_ffn2_g[l], sh3, sc3)
        x = x + 0.5 * gt3[:, None, :] * swiglu(h, ffn2_w_gate[l], ffn2_w_up[l], ffn2_w_down[l])
    return rmsnorm(x, final_g)
```

```cpp
#include <hip/hip_runtime.h>
#include <hip/hip_cooperative_groups.h>
#include <cstdio>
#include <cstdint>
#include <cmath>
namespace cg = cooperative_groups;
#define MB_NC 4
namespace pg8 {
#define PG8_LAS __attribute__((address_space(3)))
typedef unsigned short bf16_t;
typedef short bf16x8 __attribute__((ext_vector_type(8)));
typedef float f32x4 __attribute__((ext_vector_type(4)));
typedef unsigned u32x4 __attribute__((ext_vector_type(4)));
constexpr int BM = 256, BK = 64, HALF = 128, HTB = HALF * BK * 2  , STAGE_BYTES = 8 * HTB, NXCD = 8, WGM = 8;

__host__ __device__ __forceinline__ int lds_byte(int r, int c) { const int st = (r >> 4) * 2 + (c >> 5), rr = r & 15, cc = c & 31, ob = rr * 64 + cc * 2; return st * 1024 + (ob ^ (((ob >> 9) & 1) << 5)); }
__host__ __device__ __forceinline__ void stage_rc(int b, int& R, int& C) { const int st = b / 1024, sb = b % 1024, swz = sb ^ (((sb >> 9) & 1) << 5); R = (st >> 1) * 16 + swz / 64; C = (st & 1) * 32 + (swz % 64) / 2; }
__host__ __device__ __forceinline__ int perm32(int rho) { const int n = rho >> 4, i = rho & 15; return 8 * (i >> 2) + 4 * n + (i & 3); }

struct Unit { int pm, pn; };
struct Gemm { const bf16_t* A; const bf16_t* Bt; int M, N, K; size_t bstride; };

struct StaticOrder {
    int nM, nN, nwg, G, c;
    __host__ __device__ void init(int M, int N, int G_, int c_) { nM = M / BM; nN = N / BM; nwg = nM * nN; G = G_; c = c_; }
    __host__ __device__ bool next(int i, Unit& u) const {
        const long L = (long)i * G + c; if (L >= nwg) return false;
        int wgid = (int)L; { const int q = nwg / NXCD, r = nwg % NXCD, xcd = wgid % NXCD, off = wgid / NXCD; wgid = (xcd < r ? xcd * (q + 1) : r * (q + 1) + (xcd - r) * q) + off; }
        const int nig = WGM * nN, gid = wgid / nig, fm = gid * WGM, gsz = (nM - fm) < WGM ? (nM - fm) : WGM;
        u.pm = fm + ((wgid % nig) % gsz); u.pn = (wgid % nig) / gsz; return true;
    }
    __device__ __forceinline__ void a_ready(const Unit&) const {}
    __device__ __forceinline__ void done(const Unit&) const {}
};

__device__ __forceinline__ unsigned cvt_pk_bf16(float lo, float hi) { unsigned r; asm volatile("v_cvt_pk_bf16_f32 %0, %1, %2" : "=v"(r) : "v"(lo), "v"(hi)); return r; }
typedef float f32x2 __attribute__((ext_vector_type(2)));
typedef float f32x2 __attribute__((ext_vector_type(2)));
template <class Epi, class Sched, bool ALIGN_EPI = false, bool SP2 = false>
__device__ __forceinline__ void gemm_phase(PG8_LAS unsigned char* lds, const Gemm g, const Sched& S, const Epi& E, const int tid_in) {
    const int tid = tid_in, wid = __builtin_amdgcn_readfirstlane(tid >> 6), lane = tid & 63, wr = wid >> 2, wc = wid & 3, fr = lane & 15, fq = lane >> 4;
    const int K = g.K, nt = K / BK;
    unsigned voffA[2], voffB[2];
#pragma unroll
    for (int i = 0; i < 2; ++i) { int R, C; stage_rc(tid * 16 + i * 8192, R, C); const int Rb = Epi::PERM ? ((R & ~31) + perm32(R & 31)) : R;
        voffA[i] = (unsigned)(R * K + C) * 2u; voffB[i] = (unsigned)(Rb * K + C) * 2u; }
    const size_t kstep = (size_t)(BK * 2);
    const size_t hstep = (size_t)HALF * K * 2;
    const size_t tstep = 2 * hstep;
    const unsigned ldsw = (unsigned)wid * 1024u;
    const int aoff = lds_byte(wr * 64 + fr, fq * 8), boff = lds_byte(wc * 32 + fr, fq * 8);
#define PG8_SA(b, h) (((b) * 2 + (h)) * HTB)
#define PG8_SB(b, h) ((4 + (b) * 2 + (h)) * HTB)
#define PG8_STAGE(bufoff, gbase, voff) do { _Pragma("unroll") for (int _i = 0; _i < 2; ++_i) \
        __builtin_amdgcn_global_load_lds((const unsigned*)((const char*)(gbase) + (voff)[_i]), (PG8_LAS unsigned*)(lds + (bufoff) + ldsw + _i * 8192), 16, 0, 0); } while (0)
#define PG8_LDA(dst, b, h) do { _Pragma("unroll") for (int m = 0; m < 4; ++m) _Pragma("unroll") for (int k = 0; k < 2; ++k) dst[m][k] = *(const PG8_LAS bf16x8*)(lds + PG8_SA(b, h) + aoff + m * 2048 + k * 1024); } while (0)
#define PG8_LDB(dst, b, h) do { _Pragma("unroll") for (int n = 0; n < 2; ++n) _Pragma("unroll") for (int k = 0; k < 2; ++k) dst[n][k] = *(const PG8_LAS bf16x8*)(lds + PG8_SB(b, h) + boff + n * 2048 + k * 1024); } while (0)
#define PG8_MMA(ai, bj, At, Bt) do { __builtin_amdgcn_s_setprio(1); _Pragma("unroll") for (int m = 0; m < 4; ++m) _Pragma("unroll") for (int n = 0; n < 2; ++n) _Pragma("unroll") for (int k = 0; k < 2; ++k) \
        acc[ai][bj][m][n] = __builtin_amdgcn_mfma_f32_16x16x32_bf16(Bt[n][k], At[m][k], acc[ai][bj][m][n], 0, 0, 0); __builtin_amdgcn_s_setprio(0); } while (0)
#define PG8_WAIT_V(n) asm volatile("s_waitcnt vmcnt(" #n ")" ::: "memory")
#define PG8_WAIT_L(n) asm volatile("s_waitcnt lgkmcnt(" #n ")" ::: "memory")
#define PG8_BAR __builtin_amdgcn_s_barrier()
#define PG8_SCHED __builtin_amdgcn_sched_barrier(0)
    Unit cur, nxt; int ui = 0;
    if (!S.next(0, cur)) return;
    f32x4 acc[2][2][4][2];
#pragma unroll
    for (int a = 0; a < 2; ++a)
#pragma unroll
        for (int b = 0; b < 2; ++b)
#pragma unroll
            for (int m = 0; m < 4; ++m)
#pragma unroll
                for (int n = 0; n < 2; ++n) acc[a][b][m][n] = (f32x4){0.f, 0.f, 0.f, 0.f};
    bf16x8 At[4][2], B0[2][2], B1[2][2];
    const char* cA = (const char*)g.A + (size_t)cur.pm * tstep; const char* cB = (const char*)g.Bt + (size_t)cur.pn * tstep + (size_t)(cur.pm >> 5) * g.bstride;
    S.a_ready(cur);
    if constexpr (SP2) {
        PG8_STAGE(PG8_SB(0, 0), cB, voffB); PG8_STAGE(PG8_SB(0, 1), cB + hstep, voffB); PG8_STAGE(PG8_SA(0, 0), cA, voffA); PG8_STAGE(PG8_SA(0, 1), cA + hstep, voffA);
        if (wr == 1) PG8_BAR;
        PG8_WAIT_V(2); PG8_BAR;
        PG8_STAGE(PG8_SB(1, 0), cB + kstep, voffB); PG8_STAGE(PG8_SA(1, 0), cA + kstep, voffA); PG8_STAGE(PG8_SB(1, 1), cB + hstep + kstep, voffB);
        PG8_WAIT_V(6); PG8_BAR;
    } else {
        PG8_STAGE(PG8_SB(0, 0), cB, voffB); PG8_STAGE(PG8_SA(0, 0), cA, voffA); PG8_STAGE(PG8_SB(0, 1), cB + hstep, voffB); PG8_STAGE(PG8_SA(0, 1), cA + hstep, voffA);
        if (wr == 1) PG8_BAR;
        PG8_WAIT_V(4); PG8_BAR;
        PG8_STAGE(PG8_SB(1, 0), cB + kstep, voffB); PG8_STAGE(PG8_SA(1, 0), cA + kstep, voffA); PG8_STAGE(PG8_SB(1, 1), cB + hstep + kstep, voffB);
        PG8_WAIT_V(6); PG8_BAR;
    }
    for (;;) {
        const bool has_next = S.next(ui + 1, nxt);
        const char* nA = has_next ? (const char*)g.A + (size_t)nxt.pm * tstep : cA; const char* nB = has_next ? (const char*)g.Bt + (size_t)nxt.pn * tstep + (size_t)(nxt.pm >> 5) * g.bstride : cB;
        for (int t = 0; t < nt; t += 2) {
            const bool last = (t == nt - 2);
            const char* a1 = cA + (size_t)(t + 1) * kstep;
            const char* a2 = last ? nA : cA + (size_t)(t + 2) * kstep; const char* b2 = last ? nB : cB + (size_t)(t + 2) * kstep;
            const char* a3 = a2 + kstep; const char* b3 = b2 + kstep;
            if (last && has_next) S.a_ready(nxt);
            if constexpr (SP2) {
            PG8_LDB(B0, 0, 0); PG8_LDB(B1, 0, 1); PG8_SCHED; PG8_LDA(At, 0, 0); PG8_STAGE(PG8_SA(1, 1), a1 + hstep, voffA);
            PG8_WAIT_V(8); PG8_WAIT_L(0); PG8_BAR; PG8_MMA(0, 0, At, B0); PG8_MMA(0, 1, At, B1); PG8_BAR; PG8_SCHED;
            PG8_LDA(At, 0, 1); PG8_STAGE(PG8_SB(0, 0), b2, voffB); PG8_STAGE(PG8_SB(0, 1), b2 + hstep, voffB); PG8_STAGE(PG8_SA(0, 0), a2, voffA);
            PG8_WAIT_V(8); PG8_WAIT_L(0); PG8_BAR; PG8_MMA(1, 0, At, B0); PG8_MMA(1, 1, At, B1); PG8_BAR; PG8_SCHED;
            PG8_LDB(B0, 1, 0); PG8_LDB(B1, 1, 1); PG8_SCHED; PG8_LDA(At, 1, 0); PG8_STAGE(PG8_SA(0, 1), a2 + hstep, voffA);
            PG8_WAIT_V(8); PG8_WAIT_L(0); PG8_BAR; PG8_MMA(0, 0, At, B0); PG8_MMA(0, 1, At, B1); PG8_BAR; PG8_SCHED;
            PG8_LDA(At, 1, 1); PG8_STAGE(PG8_SB(1, 0), b3, voffB); PG8_STAGE(PG8_SB(1, 1), b3 + hstep, voffB); PG8_STAGE(PG8_SA(1, 0), a3, voffA);
            PG8_WAIT_V(8); PG8_WAIT_L(0); PG8_BAR; PG8_MMA(1, 0, At, B0); PG8_MMA(1, 1, At, B1); PG8_BAR; PG8_SCHED;
            } else {
            PG8_LDB(B0, 0, 0); PG8_SCHED; PG8_LDA(At, 0, 0); PG8_STAGE(PG8_SA(1, 1), a1 + hstep, voffA);
            PG8_WAIT_L(8); PG8_BAR; PG8_WAIT_L(0); PG8_MMA(0, 0, At, B0); PG8_BAR; PG8_SCHED;
            PG8_LDB(B1, 0, 1); PG8_STAGE(PG8_SB(0, 0), b2, voffB);
            PG8_BAR; PG8_WAIT_L(0); PG8_MMA(0, 1, At, B1); PG8_BAR;
            PG8_LDA(At, 0, 1); PG8_STAGE(PG8_SA(0, 0), a2, voffA);
            PG8_BAR; PG8_WAIT_L(0); PG8_MMA(1, 0, At, B0); PG8_BAR; PG8_SCHED;
            PG8_STAGE(PG8_SB(0, 1), b2 + hstep, voffB);
            PG8_WAIT_V(6); PG8_BAR; PG8_MMA(1, 1, At, B1); PG8_BAR;
            PG8_LDB(B0, 1, 0); PG8_SCHED; PG8_LDA(At, 1, 0); PG8_STAGE(PG8_SA(0, 1), a2 + hstep, voffA);
            PG8_WAIT_L(8); PG8_BAR; PG8_WAIT_L(0); PG8_MMA(0, 0, At, B0); PG8_BAR; PG8_SCHED;
            PG8_LDB(B1, 1, 1); PG8_STAGE(PG8_SB(1, 0), b3, voffB);
            PG8_BAR; PG8_WAIT_L(0); PG8_MMA(0, 1, At, B1); PG8_BAR;
            PG8_LDA(At, 1, 1); PG8_STAGE(PG8_SA(1, 0), a3, voffA);
            PG8_BAR; PG8_WAIT_L(0); PG8_MMA(1, 0, At, B0); PG8_BAR; PG8_SCHED;
            PG8_STAGE(PG8_SB(1, 1), b3 + hstep, voffB);
            PG8_WAIT_V(6); PG8_BAR; PG8_MMA(1, 1, At, B1); PG8_BAR;
            }
        }
        if constexpr (ALIGN_EPI) { if (wr == 0) PG8_BAR; }
        if constexpr (!Epi::AFTER_DRAIN) { E(acc, cur, wr, wc, fr, fq); S.done(cur); }
        if (!has_next) break;
#pragma unroll
        for (int a = 0; a < 2; ++a)
#pragma unroll
            for (int b = 0; b < 2; ++b)
#pragma unroll
                for (int m = 0; m < 4; ++m)
#pragma unroll
                    for (int n = 0; n < 2; ++n) acc[a][b][m][n] = (f32x4){0.f, 0.f, 0.f, 0.f};
        cur = nxt; cA = nA; cB = nB; ++ui;
        if constexpr (ALIGN_EPI) { if (wr == 1) PG8_BAR; }
    }
    PG8_WAIT_V(0);
    if constexpr (!ALIGN_EPI) { if (wr == 0) PG8_BAR; }
    PG8_BAR;
    if constexpr (Epi::AFTER_DRAIN) { E.fused(acc, cur, wr, wc, fr, fq, lds, wid, lane); S.done(cur); }
#undef PG8_SA
#undef PG8_SB
#undef PG8_STAGE
#undef PG8_LDA
#undef PG8_LDB
#undef PG8_MMA
#undef PG8_WAIT_V
#undef PG8_WAIT_L
#undef PG8_BAR
#undef PG8_SCHED
}
}

#ifndef MK_MULTI
#define MK_MULTI 0
#endif
#define LAS __attribute__((address_space(3)))
typedef unsigned short bf16;
typedef unsigned v4u __attribute__((ext_vector_type(4)));
typedef unsigned v2u __attribute__((ext_vector_type(2)));
typedef float f32x4 __attribute__((ext_vector_type(4)));
typedef short bf16x8 __attribute__((ext_vector_type(8)));

constexpr int NB = 2, SEQ = 8192, MTOK = NB * SEQ, DM = 1024, FF = 2816, DIN = 3212, DINP = 3328, NGU = 2 * FF;
constexpr int MQ0 = 512, MK0 = 896, MV0 = 1280, GQ0 = 1664, GZ0 = 2816, GA0 = 3200, GB0 = 3206;
constexpr int NPH = 22;
constexpr float EPS = 1e-6f;
constexpr size_t MiB = 1u << 20;
constexpr size_t WS_RS = 0, WS_MOD = 458752, WS_BIAS = 606208, CTL_ZERO = 1 * MiB;
constexpr int BIAS_L = 2 * (NGU + DINP + NGU);
constexpr size_t WS_ROPE = 1 * MiB, WS_KMEAN = 1 * MiB + 512 * 1024, WS_KNMAX = WS_KMEAN + 98304, WS_EGL = WS_KMEAN + 102400;
constexpr size_t WS_W = 2 * MiB;
constexpr size_t W_1GU = 0, W_D1 = 22 * MiB, W_IN = W_D1 + 5 * MiB + 512 * 1024, W_OUT = W_IN + 13 * MiB, W_2GU = W_OUT + 2 * MiB, W_D2 = W_2GU + 22 * MiB;
constexpr size_t WS_XB = 72 * MiB, WS_AQD = 72 * MiB, WS_AKD = 84 * MiB;
constexpr size_t WS_U = 104 * MiB, WS_Y = 208 * MiB, WS_AW = 240 * MiB, WS_AQK = 252 * MiB, WS_UD = 264 * MiB, WS_VT = 276 * MiB, WS_SV = 288 * MiB, WS_END = 300 * MiB;
constexpr size_t WS_KT = WS_W + W_IN;
static_assert(W_D2 + 5 * MiB + 512 * 1024 == 70 * MiB, "weights");
constexpr int LDS_BYTES = 163840;
constexpr size_t WS_BAR = 851968;
constexpr int LDS_BARST = 163776;

struct Params { const float* in[24]; float* out; unsigned char* ws; int ph_lo, ph_hi; };

__device__ __forceinline__ float bf2f(bf16 v) { return __uint_as_float(((unsigned)v) << 16); }
typedef float f32x2_t __attribute__((ext_vector_type(2)));
typedef __bf16 bf16x2_t __attribute__((ext_vector_type(2)));
__device__ __forceinline__ unsigned pk2(float lo, float hi) { const f32x2_t v = {lo, hi}; const bf16x2_t b = __builtin_convertvector(v, bf16x2_t); return __builtin_bit_cast(unsigned, b); }
__device__ __forceinline__ float sigmoid_f(float x) { return __builtin_amdgcn_rcpf(1.f + __expf(-x)); }
__device__ __forceinline__ float silu_f(float x) { return x * sigmoid_f(x); }
__device__ __forceinline__ float wave_sum(float v) {
#pragma unroll
    for (int o = 1; o < 64; o <<= 1) v += __shfl_xor(v, o);
    return v;
}
__device__ __forceinline__ void gadd(float* p, float v) { __hip_atomic_fetch_add(p, v, __ATOMIC_RELAXED, __HIP_MEMORY_SCOPE_AGENT); }
__device__ __forceinline__ void ladd(LAS float* p, float v) { __hip_atomic_fetch_add(p, v, __ATOMIC_RELAXED, __HIP_MEMORY_SCOPE_WORKGROUP); }
__device__ __forceinline__ bf16x8 pack8(f32x4 a, f32x4 b) {
    v4u w; w.x = pk2(a[0], a[1]); w.y = pk2(a[2], a[3]); w.z = pk2(b[0], b[1]); w.w = pk2(b[2], b[3]);
    return __builtin_bit_cast(bf16x8, w);
}
#define MFMA16(a, b, c) __builtin_amdgcn_mfma_f32_16x16x32_bf16((a), (b), (c), 0, 0, 0)

#define XB_TMO      128
#define XB_XCNT(j)  (256  + 64 * (j))
#define XB_XSUB(j)  (1280 + 64 * (j))
#define XB_XGEN(j)  (2304 + 64 * (j))
#define XB_TOP      3328
#define XB_TOPGEN   3392
#define XCD_BAR_WORDS 3456
#define XB_SPIN_CAP (1u << 18)

__device__ __forceinline__ unsigned xb_ld(unsigned* p)              { return __hip_atomic_load(p, __ATOMIC_RELAXED, __HIP_MEMORY_SCOPE_AGENT); }
__device__ __forceinline__ unsigned xb_add(unsigned* p, unsigned v) { return __hip_atomic_fetch_add(p, v, __ATOMIC_RELAXED, __HIP_MEMORY_SCOPE_AGENT); }
__device__ __forceinline__ unsigned xb_xcc_id() { return (unsigned)__builtin_amdgcn_s_getreg((3 << 11) | 20) & 0xFu; }
#define XB_SPIN(cond, bar) do { unsigned _sp = 0; while (cond) { __builtin_amdgcn_s_sleep(1); \
    if ((++_sp & 255u) == 0u) { if (xb_ld(&(bar)[XB_TMO])) break; if (_sp > XB_SPIN_CAP) { atomicAdd(&(bar)[XB_TMO], 1u); break; } } } } while (0)

struct XcdBarrier {
    unsigned* bar; unsigned x;
    volatile LAS unsigned* st;
};

__device__ __forceinline__ XcdBarrier xcd_barrier_post(unsigned* bar, volatile LAS unsigned* st) {
    XcdBarrier b; b.bar = bar; b.x = xb_xcc_id(); b.st = st;
    if (threadIdx.x == 0) (void)xb_add(&bar[XB_XCNT(b.x)], 1u);
    return b;
}
__device__ __forceinline__ void xcd_barrier_complete(unsigned* bar, unsigned x, unsigned& nloc, unsigned& nx) {
    const unsigned G = gridDim.x * gridDim.y * gridDim.z;
    unsigned sum, cnt, mine, sp = 0u;
    for (;;) {
        sum = 0u; cnt = 0u; mine = 0u;
#pragma unroll
        for (unsigned j = 0; j < 16; ++j) { const unsigned c = xb_ld(&bar[XB_XCNT(j)]); sum += c; cnt += (c > 0u) ? 1u : 0u; mine = (j == x) ? c : mine; }
        if (sum == G) break;
        __builtin_amdgcn_s_sleep(1);
        if ((++sp & 255u) == 0u) { if (xb_ld(&bar[XB_TMO])) break; if (sp > XB_SPIN_CAP) { atomicAdd(&bar[XB_TMO], 1u); break; } }
    }
    nloc = mine > 0u ? mine : 1u; nx = cnt > 0u ? cnt : 1u;
}

__device__ __forceinline__ void xcd_barrier(const XcdBarrier& b) {
    asm volatile("s_waitcnt vmcnt(0)" ::: "memory");
    __syncthreads();
    if (threadIdx.x == 0) {
        unsigned* bar = b.bar;
        __builtin_amdgcn_s_waitcnt(0);
        unsigned nloc = b.st[0], nx = b.st[1];
        if (nloc == 0u) { xcd_barrier_complete(bar, b.x, nloc, nx); b.st[0] = nloc; b.st[1] = nx; }
        const unsigned old = xb_add(&bar[XB_XSUB(b.x)], 1u);
        const unsigned gen = old / nloc;
        if (old + 1u == (gen + 1u) * nloc) {
            __builtin_amdgcn_fence(__ATOMIC_RELEASE, "agent");
            asm volatile("s_waitcnt vmcnt(0)" ::: "memory");
            const unsigned og = xb_add(&bar[XB_TOP], 1u);
            const unsigned tg = og / nx;
            if (og + 1u == (tg + 1u) * nx) xb_add(&bar[XB_TOPGEN], 1u);
            else XB_SPIN(xb_ld(&bar[XB_TOPGEN]) == tg, bar);
            __builtin_amdgcn_fence(__ATOMIC_ACQUIRE, "agent");
            xb_add(&bar[XB_XGEN(b.x)], 1u);
            asm volatile("s_waitcnt vmcnt(0)" ::: "memory");
        } else {
            XB_SPIN(xb_ld(&bar[XB_XGEN(b.x)]) == gen, bar);
            __builtin_amdgcn_fence(__ATOMIC_ACQUIRE, "agent");
            asm volatile("s_waitcnt vmcnt(0)" ::: "memory");
        }
    }
    __syncthreads();
}

struct EpiGU {
    static constexpr bool PERM = true, AFTER_DRAIN = false;
    bf16* act; const float* rs; const float* bias;
    __device__ __forceinline__ void operator()(const f32x4 (&acc)[2][2][4][2], const pg8::Unit& u, int wr, int wc, int fr, int fq) const {
        const int b = u.pm >> 5;
        const float* bb = bias + b * NGU + u.pn * 256 + wc * 32 + 8 * fq;
        const f32x4 bg0 = *(const f32x4*)(bb), bg1 = *(const f32x4*)(bb + 4), bu0 = *(const f32x4*)(bb + 128), bu1 = *(const f32x4*)(bb + 132);
        float rsall[2][4];
#pragma unroll
        for (int ai = 0; ai < 2; ++ai)
#pragma unroll
            for (int m = 0; m < 4; ++m) rsall[ai][m] = rs[u.pm * 256 + ai * 128 + wr * 64 + m * 16 + fr];
#pragma unroll
        for (int ai = 0; ai < 2; ++ai)
#pragma unroll
            for (int m = 0; m < 4; ++m) {
                const int row = u.pm * 256 + ai * 128 + wr * 64 + m * 16 + fr;
                const float rstd = rsqrtf(rsall[ai][m] * (1.f / DM) + EPS);
                const f32x4 g0 = acc[ai][0][m][0] * rstd + bg0, g1 = acc[ai][0][m][1] * rstd + bg1;
                const f32x4 u0 = acc[ai][1][m][0] * rstd + bu0, u1 = acc[ai][1][m][1] * rstd + bu1;
                v4u w;
                w.x = pk2(silu_f(g0[0]) * u0[0], silu_f(g0[1]) * u0[1]); w.y = pk2(silu_f(g0[2]) * u0[2], silu_f(g0[3]) * u0[3]);
                w.z = pk2(silu_f(g1[0]) * u1[0], silu_f(g1[1]) * u1[1]); w.w = pk2(silu_f(g1[2]) * u1[2], silu_f(g1[3]) * u1[3]);
                *(v4u*)(act + (size_t)row * FF + u.pn * 128 + wc * 32 + 8 * fq) = w;
            }
    }
};
struct EpiRes {
    static constexpr bool PERM = true, AFTER_DRAIN = false;
    const float* xin; float* x; bf16* xb; float* rsn; const float* gate; float gmul;
    __device__ __forceinline__ void operator()(const f32x4 (&acc)[2][2][4][2], const pg8::Unit& u, int wr, int wc, int fr, int fq) const {
        const int b = u.pm >> 5, col0 = u.pn * 256 + wc * 32 + 8 * fq;
        f32x4 (&ac)[2][2][4][2] = const_cast<f32x4 (&)[2][2][4][2]>(acc);
        {   f32x4 gt[2][2];
#pragma unroll
            for (int bj = 0; bj < 2; ++bj)
#pragma unroll
                for (int n = 0; n < 2; ++n) gt[bj][n] = *(const f32x4*)(gate + b * 9216 + col0 + 128 * bj + 4 * n) * gmul;
#pragma unroll
            for (int ai = 0; ai < 2; ++ai)
#pragma unroll
                for (int bj = 0; bj < 2; ++bj)
#pragma unroll
                    for (int m = 0; m < 4; ++m) { ac[ai][bj][m][0] *= gt[bj][0]; ac[ai][bj][m][1] *= gt[bj][1]; } }
#pragma unroll
        for (int bt = 0; bt < 3; ++bt) {
            const int g0 = 3 * bt, ng = bt < 2 ? 3 : 2;
            f32x4 xv[3][2][2];
#pragma unroll
            for (int gi = 0; gi < 3; ++gi) if (gi < ng) { const int ai = (g0 + gi) >> 2, m = (g0 + gi) & 3;
#pragma unroll
                for (int bj = 0; bj < 2; ++bj) { const float* pi = xin + (size_t)(u.pm * 256 + ai * 128 + wr * 64 + m * 16 + fr) * DM + col0 + 128 * bj; xv[gi][bj][0] = *(const f32x4*)pi; xv[gi][bj][1] = *(const f32x4*)(pi + 4); } }
#pragma unroll
            for (int gi = 0; gi < 3; ++gi) if (gi < ng) {
                const int ai = (g0 + gi) >> 2, m = (g0 + gi) & 3, row = u.pm * 256 + ai * 128 + wr * 64 + m * 16 + fr;
                float ss = 0.f;
#pragma unroll
                for (int bj = 0; bj < 2; ++bj) {
                    float* px = x + (size_t)row * DM + col0 + 128 * bj;
                    f32x4 x0 = xv[gi][bj][0] + ac[ai][bj][m][0], x1 = xv[gi][bj][1] + ac[ai][bj][m][1];
                    *(f32x4*)px = x0; *(f32x4*)(px + 4) = x1;
                    ss += (x0[0] * x0[0] + x0[1] * x0[1]) + (x0[2] * x0[2] + x0[3] * x0[3]) + (x1[0] * x1[0] + x1[1] * x1[1]) + (x1[2] * x1[2] + x1[3] * x1[3]);
                    v4u w; w.x = pk2(x0[0], x0[1]); w.y = pk2(x0[2], x0[3]); w.z = pk2(x1[0], x1[1]); w.w = pk2(x1[2], x1[3]);
                    *(v4u*)(xb + (size_t)row * DM + col0 + 128 * bj) = w;
                }
                ss += __shfl_xor(ss, 16); ss += __shfl_xor(ss, 32);
                if (fq == 0) gadd(rsn + row, ss);
            }
            asm volatile("" ::: "memory");
        }
    }
};
struct EpiIn {
    static constexpr bool PERM = true, AFTER_DRAIN = false;
    bf16* U; const float* rs; const float* bias; const float* rope;
    __device__ __forceinline__ void operator()(const f32x4 (&acc)[2][2][4][2], const pg8::Unit& u, int wr, int wc, int fr, int fq) const {
        const int b = u.pm >> 5, col0 = u.pn * 256 + wc * 32 + 8 * fq;
        const bool ropetile = (u.pn >= 2 && u.pn <= 4);
        const bool ropelane = ropetile && !(wc & 1) && fq < 2;
        const float* bp = bias + b * DINP + col0;
        f32x4 bv[2][2];
#pragma unroll
        for (int bj = 0; bj < 2; ++bj) { bv[bj][0] = *(const f32x4*)(bp + 128 * bj); bv[bj][1] = *(const f32x4*)(bp + 128 * bj + 4); }
        const float sg = fq == 0 ? -1.f : 1.f;
        float rsall[2][4];
#pragma unroll
        for (int ai = 0; ai < 2; ++ai)
#pragma unroll
            for (int m = 0; m < 4; ++m) rsall[ai][m] = rs[u.pm * 256 + ai * 128 + wr * 64 + m * 16 + fr];
#pragma unroll
        for (int am = 0; am < 4; ++am) {
            const int ai = am >> 1, m0 = (am & 1) * 2;
            f32x4 cs[2][4];
            if (ropelane) {
#pragma unroll
                for (int mm = 0; mm < 2; ++mm) { const float* rp = rope + (size_t)((u.pm * 256 + ai * 128 + wr * 64 + (m0 + mm) * 16 + fr) & (SEQ - 1)) * 16;
                    cs[mm][0] = *(const f32x4*)rp; cs[mm][1] = *(const f32x4*)(rp + 4); cs[mm][2] = *(const f32x4*)(rp + 8) * sg; cs[mm][3] = *(const f32x4*)(rp + 12) * sg; } }
#pragma unroll
            for (int mm = 0; mm < 2; ++mm) {
                const int m = m0 + mm, row = u.pm * 256 + ai * 128 + wr * 64 + m * 16 + fr;
                const float rst = rsqrtf(rsall[ai][m] * (1.f / DM) + EPS);
#pragma unroll
                for (int bj = 0; bj < 2; ++bj) {
                    f32x4 v0 = acc[ai][bj][m][0] * rst + bv[bj][0], v1 = acc[ai][bj][m][1] * rst + bv[bj][1];
                    if (ropetile) {
                        f32x4 p0, p1;
#pragma unroll
                        for (int j = 0; j < 4; ++j) { p0[j] = __shfl_xor(v0[j], 16); p1[j] = __shfl_xor(v1[j], 16); }
                        if (ropelane) { v0 = v0 * cs[mm][0] + p0 * cs[mm][2]; v1 = v1 * cs[mm][1] + p1 * cs[mm][3]; }
                    }
                    v4u w; w.x = pk2(v0[0], v0[1]); w.y = pk2(v0[2], v0[3]); w.z = pk2(v1[0], v1[1]); w.w = pk2(v1[2], v1[3]);
                    *(v4u*)(U + (size_t)row * DINP + col0 + 128 * bj) = w;
                }
            }
            asm volatile("" ::: "memory");
        }
    }
};

__device__ __forceinline__ void phase_pre(const Params& p, int tid, int wave, int lane) {
    const int gw = blockIdx.x * 8 + wave, NGW = gridDim.x * 8;
    const float* x = p.in[0]; bf16* xb = (bf16*)(p.ws + WS_XB); float* rs = (float*)(p.ws + WS_RS);
    for (int row0 = gw; row0 < MTOK; row0 += 8 * NGW) {
        f32x4 v[8][4];
#pragma unroll
        for (int rr = 0; rr < 8; ++rr) { const int row = row0 + rr * NGW; const f32x4* xr = (const f32x4*)(x + (size_t)(row < MTOK ? row : row0) * DM) + lane;
#pragma unroll
            for (int j = 0; j < 4; ++j) v[rr][j] = xr[64 * j]; }
#pragma unroll
        for (int rr = 0; rr < 8; ++rr) { const int row = row0 + rr * NGW; if (row < MTOK) {
            v2u* xbr = (v2u*)(xb + (size_t)row * DM) + lane; float ss = 0.f;
#pragma unroll
            for (int j = 0; j < 4; ++j) { const f32x4 t = v[rr][j]; ss += (t[0] * t[0] + t[1] * t[1]) + (t[2] * t[2] + t[3] * t[3]);
                v2u w; w.x = pk2(t[0], t[1]); w.y = pk2(t[2], t[3]); xbr[64 * j] = w; }
            ss = wave_sum(ss); if (lane == 0) rs[row] = ss; } }
    }
    const float* cvec = p.in[1]; const float* w_ada = p.in[2]; const float* b_ada = p.in[3]; float* mod = (float*)(p.ws + WS_MOD);
    for (int it = gw; it < 2304; it += NGW) {
        const int l = it / 1152, r = it % 1152, nc = r >> 5, kr = r & 31;
        const float* W = w_ada + ((size_t)l * 1024 + kr * 32) * 9216 + nc * 256 + lane * 4;
        f32x4 a0 = {0.f, 0.f, 0.f, 0.f}, a1 = a0;
#pragma unroll
        for (int k = 0; k < 32; ++k) { const f32x4 w = *(const f32x4*)(W + (size_t)k * 9216); const float c0 = silu_f(cvec[kr * 32 + k]), c1 = silu_f(cvec[1024 + kr * 32 + k]); a0 += w * c0; a1 += w * c1; }
        if (kr == 0) { const f32x4 bb = *(const f32x4*)(b_ada + l * 9216 + nc * 256 + lane * 4); a0 += bb; a1 += bb; }
        float* m0 = mod + (l * 2 + 0) * 9216 + nc * 256 + lane * 4; float* m1 = m0 + 9216;
#pragma unroll
        for (int j = 0; j < 4; ++j) { gadd(m0 + j, a0[j]); gadd(m1 + j, a1[j]); }
    }
    float* rope = (float*)(p.ws + WS_ROPE);
    for (int idx = blockIdx.x * 512 + tid; idx < SEQ * 8; idx += gridDim.x * 512) {
        const int pos = idx >> 3, i = idx & 7; const float inv = expf(-logf(500000.0f) * (float)(2 * i) / 16.0f); const float ang = (float)pos * inv;
        float s, c; sincosf(ang, &s, &c); rope[pos * 16 + i] = c; rope[pos * 16 + 8 + i] = s;
    }
}

__device__ __forceinline__ int rowmap(int n, int mode) { return mode == 0 ? n : (((n >> 7) << 8) + (n & 127) + (mode == 2 ? 128 : 0)); }
__device__ __forceinline__ void cvt_tile(const float* W, int K, int N, bf16* WT0, bf16* WT1, int mode, const float* g, const float* sc0, const float* sc1, const float* sh0, const float* sh1,
                                         float* bias0, float* bias1, int kb, int nb, LAS float* scr, int lane) {
    const int k0 = 64 * kb, n0 = 64 * nb, n = n0 + lane; const bool valid = n < N;
    {   const int r4 = lane >> 4, c4 = lane & 15; const bool v4ok = (n0 + 4 * c4) < N;
        f32x4 wv[16];
#pragma unroll
        for (int i = 0; i < 16; ++i) wv[i] = v4ok ? *(const f32x4*)(W + (size_t)(k0 + 4 * i + r4) * N + n0 + 4 * c4) : (f32x4){0.f, 0.f, 0.f, 0.f};
#pragma unroll
        for (int i = 0; i < 16; ++i) { LAS float* d = scr + (4 * i + r4) * 65 + 4 * c4; d[0] = wv[i][0]; d[1] = wv[i][1]; d[2] = wv[i][2]; d[3] = wv[i][3]; } }
    if (g) {
        float s0 = 0.f, s1 = 0.f;
#pragma unroll 8
        for (int i = 0; i < 64; ++i) { const float w = scr[i * 65 + lane]; s0 += w * sh0[k0 + i]; s1 += w * sh1[k0 + i]; }
        if (valid) { gadd(bias0 + rowmap(n, mode), s0); gadd(bias1 + rowmap(n, mode), s1); }
    }
    const int c = lane & 7;
    float k0s[8], k1s[8];
#pragma unroll
    for (int t = 0; t < 8; ++t) { if (g) { const float gk = g[k0 + 8 * c + t]; k0s[t] = gk * (1.f + sc0[k0 + 8 * c + t]); k1s[t] = gk * (1.f + sc1[k0 + 8 * c + t]); } else { k0s[t] = 1.f; k1s[t] = 1.f; } }
#pragma unroll
    for (int j = 0; j < 8; ++j) {
        const int nn = (lane >> 3) + 8 * j; const size_t row = (size_t)rowmap(n0 + nn, mode);
        float v[8];
#pragma unroll
        for (int t = 0; t < 8; ++t) v[t] = scr[(8 * c + t) * 65 + nn];
        v4u o; o.x = pk2(v[0] * k0s[0], v[1] * k0s[1]); o.y = pk2(v[2] * k0s[2], v[3] * k0s[3]); o.z = pk2(v[4] * k0s[4], v[5] * k0s[5]); o.w = pk2(v[6] * k0s[6], v[7] * k0s[7]);
        *(v4u*)(WT0 + row * K + k0 + 8 * c) = o;
        if (WT1) { v4u q; q.x = pk2(v[0] * k1s[0], v[1] * k1s[1]); q.y = pk2(v[2] * k1s[2], v[3] * k1s[3]); q.z = pk2(v[4] * k1s[4], v[5] * k1s[5]); q.w = pk2(v[6] * k1s[6], v[7] * k1s[7]);
            *(v4u*)(WT1 + row * K + k0 + 8 * c) = q; }
    }
}
__device__ __forceinline__ void phase_cvt(const Params& p, int l, LAS unsigned char* lds, int wave, int lane, int lo, int hi, int gw, int NGW) {
    LAS float* scr = (LAS float*)(lds + wave * 16640);
    unsigned char* wb = p.ws + WS_W; const float* mod0 = (const float*)(p.ws + WS_MOD) + (l * 2) * 9216; const float* mod1 = mod0 + 9216;
    float* bias = (float*)(p.ws + WS_BIAS) + l * BIAS_L;
    for (int it = lo + gw; it < hi; it += NGW) {
        int r = it;
        if (r < 1408) { const int up = r >= 704; r -= up * 704; const float* W = p.in[up ? 6 : 5] + (size_t)l * DM * FF;
            cvt_tile(W, DM, FF, (bf16*)(wb + W_1GU), (bf16*)(wb + W_1GU) + (size_t)NGU * DM, 1 + up, p.in[4] + l * DM, mod0 + 1024, mod1 + 1024, mod0, mod1, bias, bias + NGU, r / 44, r % 44, scr, lane); continue; }
        r -= 1408;
        if (r < 704) { cvt_tile(p.in[7] + (size_t)l * FF * DM, FF, DM, (bf16*)(wb + W_D1), nullptr, 0, nullptr, nullptr, nullptr, nullptr, nullptr, nullptr, nullptr, r / 16, r % 16, scr, lane); continue; }
        r -= 704;
        if (r < 832) { cvt_tile(p.in[9] + (size_t)l * DM * DIN, DM, DIN, (bf16*)(wb + W_IN), (bf16*)(wb + W_IN) + (size_t)DINP * DM, 0, p.in[8] + l * DM, mod0 + 4096, mod1 + 4096, mod0 + 3072, mod1 + 3072,
                                bias + 2 * NGU, bias + 2 * NGU + DINP, r / 52, r % 52, scr, lane); continue; }
        r -= 832;
        if (r < 256) { cvt_tile(p.in[18] + (size_t)l * DM * DM, DM, DM, (bf16*)(wb + W_OUT), nullptr, 0, nullptr, nullptr, nullptr, nullptr, nullptr, nullptr, nullptr, r / 16, r % 16, scr, lane); continue; }
        r -= 256;
        if (r < 1408) { const int up = r >= 704; r -= up * 704; const float* W = p.in[up ? 21 : 20] + (size_t)l * DM * FF;
            cvt_tile(W, DM, FF, (bf16*)(wb + W_2GU), (bf16*)(wb + W_2GU) + (size_t)NGU * DM, 1 + up, p.in[19] + l * DM, mod0 + 7168, mod1 + 7168, mod0 + 6144, mod1 + 6144,
                     bias + 2 * NGU + 2 * DINP, bias + 2 * NGU + 2 * DINP + NGU, r / 44, r % 44, scr, lane); continue; }
        r -= 1408;
        cvt_tile(p.in[22] + (size_t)l * FF * DM, FF, DM, (bf16*)(wb + W_D2), nullptr, 0, nullptr, nullptr, nullptr, nullptr, nullptr, nullptr, nullptr, r / 16, r % 16, scr, lane);
    }
}

__device__ __forceinline__ void conv_item(const Params& p, int l, int item, LAS float* hs, int tid, int wave, int lane) {
    const bf16* U = (const bf16*)(p.ws + WS_U); bf16* Y = (bf16*)(p.ws + WS_Y);
    const int t0 = item * 64, b = t0 >> 13, tp0 = t0 & (SEQ - 1);
    const int c = tid & 255, hf = tid >> 8;
    float w[31], acc[32];
#pragma unroll
    for (int k = 0; k < 31; ++k) w[k] = p.in[10][(l * 31 + k) * 256 + c];
    const float bias = p.in[11][l * 256 + c];
    {   v4u av[6], gv[6];
#pragma unroll
        for (int i = 0; i < 6; ++i) { const int ti = tid + 512 * i, r = ti >> 5, c8 = ti & 31, tp = tp0 - 30 + r; av[i] = (v4u){0u, 0u, 0u, 0u}; gv[i] = av[i];
            if (ti < 3008 && tp >= 0) { const bf16* ur = U + (size_t)(b * SEQ + tp) * DINP + 8 * c8; av[i] = *(const v4u*)ur; gv[i] = *(const v4u*)(ur + 256); } }
#pragma unroll
        for (int i = 0; i < 6; ++i) { const int ti = tid + 512 * i, r = ti >> 5, c8 = ti & 31;
            if (ti < 3008) { const unsigned aw[4] = {av[i].x, av[i].y, av[i].z, av[i].w}, gw[4] = {gv[i].x, gv[i].y, gv[i].z, gv[i].w};
                float hv8[8];
#pragma unroll
                for (int j = 0; j < 4; ++j) { hv8[2 * j] = __uint_as_float(aw[j] << 16) * sigmoid_f(__uint_as_float(gw[j] << 16));
                    hv8[2 * j + 1] = __uint_as_float(aw[j] & 0xffff0000u) * sigmoid_f(__uint_as_float(gw[j] & 0xffff0000u)); }
                *(LAS f32x4*)(hs + r * 256 + 8 * c8) = (f32x4){hv8[0], hv8[1], hv8[2], hv8[3]}; *(LAS f32x4*)(hs + r * 256 + 8 * c8 + 4) = (f32x4){hv8[4], hv8[5], hv8[6], hv8[7]}; } }
    }
    __syncthreads();
#pragma unroll
    for (int r = 0; r < 32; ++r) acc[r] = bias;
#pragma unroll
    for (int j = 0; j < 62; ++j) { const float hv = hs[(32 * hf + j) * 256 + c];
#pragma unroll
        for (int r = 0; r < 32; ++r) { const int k = j - r; if (k >= 0 && k < 31) acc[r] += hv * w[k]; } }
    __syncthreads();
#pragma unroll
    for (int r = 0; r < 32; ++r) hs[(32 * hf + r) * 256 + c] = acc[r];
    __syncthreads();
    const float* lg = p.in[12] + l * 256; const float* lb = p.in[13] + l * 256;
    const f32x4 lgv = *(const f32x4*)(lg + 4 * lane), lbv = *(const f32x4*)(lb + 4 * lane);
    for (int rr = 0; rr < 8; ++rr) { const int row = wave * 8 + rr;
        f32x4 v = *(const LAS f32x4*)(hs + row * 256 + 4 * lane);
        const float mu = wave_sum((v[0] + v[1]) + (v[2] + v[3])) * (1.f / 256.f);
        v -= mu;
        const float rstd = rsqrtf(wave_sum((v[0] * v[0] + v[1] * v[1]) + (v[2] * v[2] + v[3] * v[3])) * (1.f / 256.f) + EPS);
        const f32x4 yv = v * rstd * lgv + lbv;
        v2u w; w.x = pk2(silu_f(yv[0]), silu_f(yv[1])); w.y = pk2(silu_f(yv[2]), silu_f(yv[3]));
        *(v2u*)(Y + (size_t)(t0 + row) * DM + 4 * lane) = w; }
    __syncthreads();
}
__device__ __forceinline__ void mobaprep_item(const Params& p, int item, LAS unsigned char* lds, int tid) {
    const bf16* U = (const bf16*)(p.ws + WS_U);
    const int bh = item >> 5, j = item & 31, b = bh / 6, h = bh % 6; const size_t base = (size_t)b * SEQ + j * 256;
    LAS unsigned* vs = (LAS unsigned*)lds;
    LAS unsigned* ksl = (LAS unsigned*)(lds + 33792);
    LAS float* ksum = (LAS float*)(lds + 67584);
    LAS unsigned* kmx = (LAS unsigned*)(lds + 67584 + 2048);
    v4u kv[4], vv[4];
#pragma unroll
    for (int i = 0; i < 4; ++i) { const int idx = tid + 512 * i, row = idx >> 3, pc = idx & 7; const bf16* rp = U + (base + row) * DINP + h * 64 + 8 * pc; kv[i] = *(const v4u*)(rp + MK0); vv[i] = *(const v4u*)(rp + MV0); }
    if (tid == 0) kmx[0] = 0u;
    __syncthreads();
    float nmax = 0.f;
#pragma unroll
    for (int i = 0; i < 4; ++i) { const int idx = tid + 512 * i, row = idx >> 3, pc = idx & 7;
        LAS unsigned* dk = ksl + row * 33 + 4 * pc; dk[0] = kv[i].x; dk[1] = kv[i].y; dk[2] = kv[i].z; dk[3] = kv[i].w;
        LAS unsigned* dv = vs + row * 33 + 4 * pc; dv[0] = vv[i].x; dv[1] = vv[i].y; dv[2] = vv[i].z; dv[3] = vv[i].w;
        const unsigned w4[4] = {kv[i].x, kv[i].y, kv[i].z, kv[i].w}; float ss = 0.f;
#pragma unroll
        for (int t = 0; t < 4; ++t) { const float a0 = __uint_as_float(w4[t] << 16), a1 = __uint_as_float(w4[t] & 0xffff0000u); ss += a0 * a0 + a1 * a1; }
        ss += __shfl_xor(ss, 1); ss += __shfl_xor(ss, 2); ss += __shfl_xor(ss, 4);
        nmax = fmaxf(nmax, ss); }
#pragma unroll
    for (int o = 8; o < 64; o <<= 1) nmax = fmaxf(nmax, __shfl_xor(nmax, o));
    if ((tid & 63) == 0) __hip_atomic_fetch_max(kmx, __float_as_uint(sqrtf(nmax)), __ATOMIC_RELAXED, __HIP_MEMORY_SCOPE_WORKGROUP);
    __syncthreads();
    { const int d = tid & 63, part = tid >> 6; const LAS bf16* kb = (const LAS bf16*)ksl; float s = 0.f;
#pragma unroll 8
      for (int r = 0; r < 32; ++r) s += bf2f(kb[(part * 32 + r) * 66 + d]);
      ksum[part * 64 + d] = s; }
    {
        bf16* Kt = (bf16*)(p.ws + WS_KT) + ((size_t)bh * 256 + j * 8) * 2048; bf16* Vt = (bf16*)(p.ws + WS_VT) + ((size_t)bh * 256 + j * 8) * 2048;
        const LAS bf16* vsb = (const LAS bf16*)vs;
#pragma unroll
        for (int i = 0; i < 4; ++i) { const int q = tid + 512 * i, c8 = q >> 8, pidx = q & 255, m = pidx & 15, g = (pidx >> 4) & 3;
            { const int ks = (pidx >> 6) & 1, tt = pidx >> 7, key = 32 * c8 + 8 * (m >> 2) + 4 * tt + (m & 3); const LAS unsigned* sp = ksl + key * 33 + 16 * ks + 4 * g;
              v4u o; o.x = sp[0]; o.y = sp[1]; o.z = sp[2]; o.w = sp[3]; *(v4u*)(Kt + (size_t)c8 * 2048 + pidx * 8) = o; }
            { const int dt = pidx >> 6, d = 16 * dt + m, k0 = 32 * c8 + 8 * g; unsigned w[4];
#pragma unroll
              for (int t = 0; t < 4; ++t) w[t] = (unsigned)vsb[(k0 + 2 * t) * 66 + d] | ((unsigned)vsb[(k0 + 2 * t + 1) * 66 + d] << 16);
              v4u o; o.x = w[0]; o.y = w[1]; o.z = w[2]; o.w = w[3]; *(v4u*)(Vt + (size_t)c8 * 2048 + pidx * 8) = o; } }
    }
    __syncthreads();
    if (tid < 64) { float s = 0.f; for (int q = 0; q < 8; ++q) s += ksum[q * 64 + tid]; ((float*)(p.ws + WS_KMEAN))[(size_t)item * 64 + tid] = s * (1.f / 256.f); }
    if (tid == 0) ((float*)(p.ws + WS_KNMAX))[item] = __uint_as_float(kmx[0]);
    __syncthreads();
}
__device__ __forceinline__ int perm8(int pc, int t) { return 32 * (pc >> 2) + 16 * (t >> 2) + 4 * (pc & 3) + (t & 3); }
__device__ __forceinline__ void gdnprep_item(const Params& p, int l, int ci, LAS unsigned char* lds, int tid_in, int lane_in, int gvar = 0) {
    int tid = tid_in; asm volatile("" : "+v"(tid)); const int lane = tid & 63; (void)lane_in;
    const bf16* U = (const bf16*)(p.ws + WS_U);
    const int bh = ci >> 7, n = ci & 127, b = bh / 6, h = bh % 6;
    LAS float* qs = (LAS float*)lds; LAS float* ks = qs + 4160; LAS float* vs = ks + 4160; LAS float* Lm = vs + 4160; LAS float* Tm = Lm + 4160; LAS float* qk = Tm + 4160; LAS float* us = qk + 4160;
    LAS float* gc = us + 4160; LAS float* bet = gc + 64; LAS float* eg = bet + 64; LAS float* tmpP = eg + 64;
    LAS unsigned char* kb = lds + 120832; LAS unsigned char* qb = lds + 130048; LAS unsigned char* vT = lds + 139264; LAS unsigned char* kT = lds + 148480;
    const int wv = tid >> 6;
    const float* cw = p.in[14] + (size_t)l * 4 * 1152;
    const size_t rbase = (size_t)b * SEQ + n * 64;
    LAS bf16* raw = (LAS bf16*)Lm;
    LAS float* cws = us;
    float ga = 0.f, gb = 0.f, galog = 0.f, gdt = 0.f;
    if (tid < 64) { ga = bf2f(U[(rbase + tid) * DINP + GA0 + h]); gb = bf2f(U[(rbase + tid) * DINP + GB0 + h]); galog = p.in[15][l * 6 + h]; gdt = p.in[16][l * 6 + h]; }
    {   float cwv[2];
#pragma unroll
        for (int i = 0; i < 2; ++i) { const int t = tid + 512 * i; cwv[i] = 0.f; if (t < 768) { const int k = t / 192, cc = t % 192; cwv[i] = cw[k * 1152 + (cc >> 6) * 384 + h * 64 + (cc & 63)]; } }
        v4u rv[4];
#pragma unroll
        for (int i = 0; i < 4; ++i) { const int pi = tid + 512 * i; rv[i] = (v4u){0u, 0u, 0u, 0u};
            if (pi < 1608) { const int r = pi / 24, q = pi % 24, grp = q >> 3, pc = q & 7, tp = n * 64 - 3 + r;
                if (tp >= 0) rv[i] = *(const v4u*)(U + ((size_t)b * SEQ + tp) * DINP + GQ0 + grp * 384 + h * 64 + 8 * pc); } }
#pragma unroll
        for (int i = 0; i < 4; ++i) { const int pi = tid + 512 * i; if (pi < 1608) { const int r = pi / 24, q = pi % 24; *(LAS v4u*)(raw + r * 192 + 8 * q) = rv[i]; } }
#pragma unroll
        for (int i = 0; i < 2; ++i) { const int t = tid + 512 * i; if (t < 768) cws[t] = cwv[i]; }
    }
    __syncthreads();
    {
        const int r = tid >> 3, pt = tid & 7; float o[3][8];
#pragma unroll
        for (int grp = 0; grp < 3; ++grp) {
            const int cc = grp * 64 + pt * 8; float a[8];
#pragma unroll
            for (int t = 0; t < 8; ++t) a[t] = 0.f;
#pragma unroll
            for (int k = 0; k < 4; ++k) { const v4u rw = *(const LAS v4u*)(raw + (r + k) * 192 + cc); const f32x4 c0 = *(const LAS f32x4*)(cws + k * 192 + cc), c1 = *(const LAS f32x4*)(cws + k * 192 + cc + 4);
                a[0] += __uint_as_float(rw.x << 16) * c0[0]; a[1] += __uint_as_float(rw.x & 0xffff0000u) * c0[1]; a[2] += __uint_as_float(rw.y << 16) * c0[2]; a[3] += __uint_as_float(rw.y & 0xffff0000u) * c0[3];
                a[4] += __uint_as_float(rw.z << 16) * c1[0]; a[5] += __uint_as_float(rw.z & 0xffff0000u) * c1[1]; a[6] += __uint_as_float(rw.w << 16) * c1[2]; a[7] += __uint_as_float(rw.w & 0xffff0000u) * c1[3]; }
#pragma unroll
            for (int t = 0; t < 8; ++t) o[grp][t] = silu_f(a[t]);
        }
        if (tid < 64) {
            const float xx = ga + gdt; const float sp = xx > 20.f ? xx : log1pf(expf(xx));
            float g = -expf(galog) * sp;
#pragma unroll
            for (int o2 = 1; o2 < 64; o2 <<= 1) { const float t = __shfl_up(g, o2); if (lane >= o2) g += t; }
            gc[tid] = g; bet[tid] = sigmoid_f(gb); eg[tid] = expf(g);
        }
        float sq = 0.f, sk = 0.f;
#pragma unroll
        for (int t = 0; t < 8; ++t) { sq += o[0][t] * o[0][t]; sk += o[1][t] * o[1][t]; }
        sq += __shfl_xor(sq, 1); sq += __shfl_xor(sq, 2); sq += __shfl_xor(sq, 4); sk += __shfl_xor(sk, 1); sk += __shfl_xor(sk, 2); sk += __shfl_xor(sk, 4);
        const float rq = rsqrtf(sq + EPS) * 0.125f, rk = rsqrtf(sk + EPS);
        float qn[8], kn[8];
#pragma unroll
        for (int t = 0; t < 8; ++t) { qn[t] = o[0][t] * rq; kn[t] = o[1][t] * rk; qs[r * 65 + pt * 8 + t] = qn[t]; ks[r * 65 + pt * 8 + t] = kn[t]; vs[r * 65 + pt * 8 + t] = o[2][t]; }
        v4u w; w.x = pk2(qn[0], qn[1]); w.y = pk2(qn[2], qn[3]); w.z = pk2(qn[4], qn[5]); w.w = pk2(qn[6], qn[7]); *(LAS v4u*)(qb + r * 144 + pt * 16) = w;
        w.x = pk2(kn[0], kn[1]); w.y = pk2(kn[2], kn[3]); w.z = pk2(kn[4], kn[5]); w.w = pk2(kn[6], kn[7]); *(LAS v4u*)(kb + r * 144 + pt * 16) = w;
#pragma unroll
        for (int t = 0; t < 8; ++t) { ((LAS bf16*)kT)[(pt * 8 + t) * 72 + r] = (bf16)(pk2(kn[t], 0.f) & 0xffffu); ((LAS bf16*)vT)[(pt * 8 + t) * 72 + r] = (bf16)(pk2(o[2][t], 0.f) & 0xffffu); }
    }
    if (gvar == 1) { __syncthreads(); return; }
    __syncthreads();
    {   const int kind = wv >> 2, mt = wv & 3, n16 = lane & 15, g4 = lane >> 4;
        const LAS unsigned char* ap = (kind ? qb : kb) + (16 * mt + n16) * 144 + g4 * 16;
        const bf16x8 a0 = *(const LAS bf16x8*)ap, a1 = *(const LAS bf16x8*)(ap + 64);
#pragma unroll
        for (int nt = 0; nt < 4; ++nt) { const LAS unsigned char* bp = kb + (16 * nt + n16) * 144 + g4 * 16;
            f32x4 acc = {0.f, 0.f, 0.f, 0.f}; acc = MFMA16(a0, *(const LAS bf16x8*)bp, acc); acc = MFMA16(a1, *(const LAS bf16x8*)(bp + 64), acc);
            const int sI = 16 * nt + n16; const float gs = gc[sI];
#pragma unroll
            for (int i = 0; i < 4; ++i) { const int c = 16 * mt + 4 * g4 + i; const float dec = (sI <= c) ? expf(gc[c] - gs) : 0.f;
                if (kind == 0) { Lm[c * 65 + sI] = (sI < c) ? bet[c] * acc[i] * dec : 0.f; Tm[c * 65 + sI] = 0.f; } else qk[c * 65 + sI] = acc[i] * dec; } } }
    __syncthreads();
    if (gvar == 2) { __syncthreads(); return; }
    if (tid < 64) { const int blk = tid >> 4, cc = tid & 15; float t[16];
#pragma unroll
        for (int r = 0; r < 16; ++r) { float v = (r == cc) ? 1.f : 0.f;
#pragma unroll
            for (int j = 0; j < 16; ++j) if (j < r) v -= Lm[(16 * blk + r) * 65 + 16 * blk + j] * t[j];
            t[r] = v; }
#pragma unroll
        for (int r = 0; r < 16; ++r) Tm[(16 * blk + r) * 65 + 16 * blk + cc] = t[r]; }
    __syncthreads();
#pragma unroll
    for (int dist = 1; dist < 4; ++dist) { const int np = 4 - dist;
        for (int idx = tid; idx < np * 256; idx += 512) { const int pr = idx >> 8, r = (idx >> 4) & 15, cc = idx & 15, i = pr + dist, j = pr; float a0 = 0.f, a1 = 0.f;
            const LAS float* lp = Lm + (16 * i + r) * 65 + 16 * j; const LAS float* tp = Tm + (16 * j) * 65 + 16 * j + cc;
#pragma unroll 8
            for (int k = 0; k < 16 * dist; k += 2) { a0 += lp[k] * tp[k * 65]; a1 += lp[k + 1] * tp[(k + 1) * 65]; }
            tmpP[pr * 272 + r * 17 + cc] = a0 + a1; }
        __syncthreads();
        for (int idx = tid; idx < np * 256; idx += 512) { const int pr = idx >> 8, r = (idx >> 4) & 15, cc = idx & 15, i = pr + dist, j = pr; float a0 = 0.f, a1 = 0.f;
#pragma unroll
            for (int k = 0; k < 16; k += 2) { a0 += Tm[(16 * i + r) * 65 + 16 * i + k] * tmpP[pr * 272 + k * 17 + cc]; a1 += Tm[(16 * i + r) * 65 + 16 * i + k + 1] * tmpP[pr * 272 + (k + 1) * 17 + cc]; }
            Tm[(16 * i + r) * 65 + 16 * j + cc] = -(a0 + a1); }
        __syncthreads();
    }
    if (gvar == 3) { __syncthreads(); return; }
    {   const int c = tid >> 3, pt = tid & 7; float tb[8], tg[8];
#pragma unroll
        for (int t = 0; t < 8; ++t) { const int sI = pt * 8 + t; tb[t] = Tm[c * 65 + sI] * bet[sI]; tg[t] = tb[t] * eg[sI]; }
        v4u w; w.x = pk2(tb[0], tb[1]); w.y = pk2(tb[2], tb[3]); w.z = pk2(tb[4], tb[5]); w.w = pk2(tb[6], tb[7]); *(LAS v4u*)(kb + c * 144 + pt * 16) = w;
        w.x = pk2(tg[0], tg[1]); w.y = pk2(tg[2], tg[3]); w.z = pk2(tg[4], tg[5]); w.w = pk2(tg[6], tg[7]); *(LAS v4u*)(qb + c * 144 + pt * 16) = w; }
    __syncthreads();
    {   const int kind = wv >> 2, mt = wv & 3, n16 = lane & 15, g4 = lane >> 4;
        const LAS unsigned char* ap = (kind ? qb : kb) + (16 * mt + n16) * 144 + g4 * 16;
        const bf16x8 a0 = *(const LAS bf16x8*)ap, a1 = *(const LAS bf16x8*)(ap + 64);
        LAS float* dst = kind ? Lm : us;
#pragma unroll
        for (int nt = 0; nt < 4; ++nt) { const LAS unsigned char* bp = (kind ? kT : vT) + (16 * nt + n16) * 144 + g4 * 16;
            f32x4 acc = {0.f, 0.f, 0.f, 0.f}; acc = MFMA16(a0, *(const LAS bf16x8*)bp, acc); acc = MFMA16(a1, *(const LAS bf16x8*)(bp + 64), acc);
#pragma unroll
            for (int i = 0; i < 4; ++i) dst[(16 * mt + 4 * g4 + i) * 65 + 16 * nt + n16] = acc[i]; } }
    __syncthreads();
    { const int row = 16 * (tid >> 7) + (tid & 15), pc = 4 * ((tid >> 6) & 1) + ((tid >> 4) & 3); const size_t off = (size_t)ci * 4096 + (size_t)tid * 8;
      float v[8]; v4u o;
      const float egr = eg[row], gl = gc[63];
#pragma unroll
      for (int t = 0; t < 8; ++t) v[t] = Lm[row * 65 + perm8(pc, t)];
      o.x = pk2(v[0], v[1]); o.y = pk2(v[2], v[3]); o.z = pk2(v[4], v[5]); o.w = pk2(v[6], v[7]); *(v4u*)((bf16*)(p.ws + WS_AW) + off) = o;
#pragma unroll
      for (int t = 0; t < 8; ++t) v[t] = qk[row * 65 + perm8(pc, t)];
      o.x = pk2(v[0], v[1]); o.y = pk2(v[2], v[3]); o.z = pk2(v[4], v[5]); o.w = pk2(v[6], v[7]); *(v4u*)((bf16*)(p.ws + WS_AQK) + off) = o;
#pragma unroll
      for (int t = 0; t < 8; ++t) v[t] = qs[row * 65 + perm8(pc, t)] * egr;
      o.x = pk2(v[0], v[1]); o.y = pk2(v[2], v[3]); o.z = pk2(v[4], v[5]); o.w = pk2(v[6], v[7]); *(v4u*)((bf16*)(p.ws + WS_AQD) + off) = o;
#pragma unroll
      for (int t = 0; t < 8; ++t) { const int s = perm8(pc, t); v[t] = ks[s * 65 + row] * expf(gl - gc[s]); }
      o.x = pk2(v[0], v[1]); o.y = pk2(v[2], v[3]); o.z = pk2(v[4], v[5]); o.w = pk2(v[6], v[7]); *(v4u*)((bf16*)(p.ws + WS_AKD) + off) = o;
      const int e0 = 8 * tid, slice = e0 >> 10, mt = (e0 >> 8) & 3;
#pragma unroll
      for (int t = 0; t < 8; ++t) { const int ln = (2 * tid + (t >> 2)) & 63, i = t & 3; v[t] = us[(16 * mt + 4 * (ln >> 4) + i) * 65 + 16 * slice + (ln & 15)]; }
      o.x = pk2(v[0], v[1]); o.y = pk2(v[2], v[3]); o.z = pk2(v[4], v[5]); o.w = pk2(v[6], v[7]); *(v4u*)((bf16*)(p.ws + WS_UD) + (size_t)ci * 4096 + e0) = o;
      if (tid == 0) ((float*)(p.ws + WS_EGL))[ci] = eg[63]; }
    __syncthreads();
}

template <int VAR>
__device__ __forceinline__ void gdn_scan(const Params& p, int l, int bh, LAS unsigned char* lds, int tid, int wave, int lane) {
    constexpr int BUFB = 26624, OFF_U = 18432, OFF_EG = 3 * BUFB;
    LAS float* egls = (LAS float*)(lds + OFF_EG);
    const int ci0 = bh * 128;
    if (wave >= 4) {
        const int t = tid - 256;
        const unsigned char* src[3] = { p.ws + WS_AW, p.ws + WS_AKD, p.ws + WS_UD };
        const float* EGL = (const float*)(p.ws + WS_EGL);
        unsigned ldA[2], ldL[2]; size_t gA[2];
#pragma unroll
        for (int j = 0; j < 2; ++j) { const int q = t + 256 * j; ldA[j] = (16 * (q >> 7) + (q & 15)) * 144 + (4 * ((q >> 6) & 1) + ((q >> 4) & 3)) * 16; ldL[j] = q * 16; gA[j] = (size_t)ci0 * 8192 + q * 16; }
        v4u pf[3][6]; float pe[3] = {0.f, 0.f, 0.f};
#define SC_LOAD(S, M) do { const int mo_ = (M) < 127 ? (M) : 127; \
        _Pragma("unroll") for (int i_ = 0; i_ < 3; ++i_) _Pragma("unroll") for (int j_ = 0; j_ < 2; ++j_) pf[S][2 * i_ + j_] = *(const v4u*)(src[i_] + gA[j_] + (size_t)mo_ * 8192); \
        pe[S] = EGL[ci0 + mo_]; } while (0)
#define SC_STORE(S, BUF) do { LAS unsigned char* d_ = lds + (BUF) * BUFB; \
        _Pragma("unroll") for (int i_ = 0; i_ < 2; ++i_) _Pragma("unroll") for (int j_ = 0; j_ < 2; ++j_) *(LAS v4u*)(d_ + i_ * 9216 + ldA[j_]) = pf[S][2 * i_ + j_]; \
        _Pragma("unroll") for (int j_ = 0; j_ < 2; ++j_) *(LAS v4u*)(d_ + OFF_U + ldL[j_]) = pf[S][4 + j_]; \
        if (t == 0) egls[BUF] = pe[S]; } while (0)
        SC_LOAD(0, 0); SC_LOAD(1, 1); SC_STORE(0, 0); SC_LOAD(2, 2); SC_STORE(1, 1); SC_LOAD(0, 3); SC_LOAD(1, 4);
        __syncthreads();
#define SC_LSTEP(N, SX) do { const int n = (N); if (n < 128) { SC_STORE(SX, SX); SC_LOAD(SX, n + 5); __syncthreads(); } } while (0)
        for (int n0 = 0; n0 < 128; n0 += 3) { SC_LSTEP(n0, 2); SC_LSTEP(n0 + 1, 0); SC_LSTEP(n0 + 2, 1); }
#undef SC_LSTEP
#undef SC_LOAD
#undef SC_STORE
    } else {
        const int n16 = lane & 15, g = lane >> 4;
        unsigned char* SV = p.ws + WS_SV + (size_t)ci0 * 8192 + wave * 2048 + lane * 16;
        f32x4 S[4]; bf16x8 Sb[2];
#pragma unroll
        for (int i = 0; i < 4; ++i) S[i] = (f32x4){0.f, 0.f, 0.f, 0.f};
        Sb[0] = (bf16x8){0, 0, 0, 0, 0, 0, 0, 0}; Sb[1] = Sb[0];
        __syncthreads();
#define AFR(base, mat, mt, ks) (*(const LAS bf16x8*)((base) + (mat) * 9216 + (mt) * (16 * 144) + (ks) * 64))
        bf16x8 fa[4][2]; v2u uw[4]; float egl;
        {   const LAS unsigned char* ab = lds + (n16 * 144) + g * 16;
#pragma unroll
            for (int mt = 0; mt < 4; ++mt) { fa[mt][0] = AFR(ab, 0, mt, 0); fa[mt][1] = AFR(ab, 0, mt, 1); uw[mt] = *(const LAS v2u*)(lds + OFF_U + ((wave * 4 + mt) * 64 + lane) * 8); }
            egl = egls[0]; }
        int cb = 0;
        for (int n = 0; n < 128; ++n) {
            const int nb = (cb == 2) ? 0 : cb + 1;
            const LAS unsigned char* ab = lds + cb * BUFB + (n16 * 144) + g * 16;
            *(bf16x8*)(SV + (size_t)n * 8192) = Sb[0]; *(bf16x8*)(SV + (size_t)n * 8192 + 1024) = Sb[1];
            bf16x8 fb[4][2];
#pragma unroll
            for (int mt = 0; mt < 4; ++mt) { fb[mt][0] = AFR(ab, 1, mt, 0); fb[mt][1] = AFR(ab, 1, mt, 1); }
            f32x4 vn[4];
#pragma unroll
            for (int mt = 0; mt < 4; ++mt) {
                f32x4 uc; uc[0] = __uint_as_float(uw[mt].x << 16); uc[1] = __uint_as_float(uw[mt].x & 0xffff0000u); uc[2] = __uint_as_float(uw[mt].y << 16); uc[3] = __uint_as_float(uw[mt].y & 0xffff0000u);
                f32x4 a = {0.f, 0.f, 0.f, 0.f}; a = MFMA16(fa[mt][0], Sb[0], a); a = MFMA16(fa[mt][1], Sb[1], a); vn[mt] = uc - a; }
            bf16x8 vb[2]; vb[0] = pack8(vn[0], vn[1]); vb[1] = pack8(vn[2], vn[3]);
            const float eg_cur = egl;
            {
                const LAS unsigned char* an = lds + nb * BUFB + (n16 * 144) + g * 16;
#pragma unroll
                for (int mt = 0; mt < 4; ++mt) { fa[mt][0] = AFR(an, 0, mt, 0); fa[mt][1] = AFR(an, 0, mt, 1); uw[mt] = *(const LAS v2u*)(lds + nb * BUFB + OFF_U + ((wave * 4 + mt) * 64 + lane) * 8); }
                egl = egls[nb]; }
#pragma unroll
            for (int mt = 0; mt < 4; ++mt) { f32x4 a = S[mt] * eg_cur; a = MFMA16(fb[mt][0], vb[0], a); a = MFMA16(fb[mt][1], vb[1], a); S[mt] = a; }
            Sb[0] = pack8(S[0], S[1]); Sb[1] = pack8(S[2], S[3]);
            cb = nb;
            __syncthreads();
        }
#undef AFR
    }
    __syncthreads();
}
struct OphRegs { bf16x8 Sb[2], aw[4][2], aq[2][2], ak[2][2]; v2u un[4]; v4u zv; };
__device__ __forceinline__ void gdn_out_load(const Params& p, int ci, OphRegs& R, int tid, int wave, int lane) {
    const bf16* U = (const bf16*)(p.ws + WS_U);
    const int bh = ci >> 7, n = ci & 127, b = bh / 6, h = bh % 6;
    const int sl = wave & 3, hm = wave >> 2, n16 = lane & 15, g = lane >> 4;
    const size_t co = (size_t)ci * 4096;
    const bf16* SV = (const bf16*)(p.ws + WS_SV) + co; const bf16* AW = (const bf16*)(p.ws + WS_AW) + co; const bf16* AQD = (const bf16*)(p.ws + WS_AQD) + co;
    const bf16* AQK = (const bf16*)(p.ws + WS_AQK) + co; const bf16* UD = (const bf16*)(p.ws + WS_UD) + co;
    const int zrow = tid >> 3, zpc = tid & 7; const size_t grow = (size_t)b * SEQ + n * 64 + zrow;
    R.zv = *(const v4u*)(U + grow * DINP + GZ0 + h * 64 + 8 * zpc);
#pragma unroll
    for (int ks = 0; ks < 2; ++ks) R.Sb[ks] = *(const bf16x8*)(SV + ((sl * 2 + ks) * 64 + lane) * 8);
#pragma unroll
    for (int mt = 0; mt < 4; ++mt) { R.un[mt] = *(const v2u*)(UD + ((sl * 4 + mt) * 64 + lane) * 4);
#pragma unroll
        for (int ks = 0; ks < 2; ++ks) R.aw[mt][ks] = *(const bf16x8*)(AW + (((mt * 2 + ks) * 4 + g) * 16 + n16) * 8); }
#pragma unroll
    for (int mi = 0; mi < 2; ++mi)
#pragma unroll
        for (int ks = 0; ks < 2; ++ks) { const int off = ((((2 * hm + mi) * 2 + ks) * 4 + g) * 16 + n16) * 8; R.aq[mi][ks] = *(const bf16x8*)(AQD + off); R.ak[mi][ks] = *(const bf16x8*)(AQK + off); }
}
__device__ __forceinline__ void gdn_out_compute(const Params& p, int l, int ci, const OphRegs& R, LAS unsigned char* lds, int tid, int wave, int lane) {
    bf16* Y = (bf16*)(p.ws + WS_Y);
    const int bh = ci >> 7, n = ci & 127, b = bh / 6, h = bh % 6;
    const int sl = wave & 3, hm = wave >> 2, n16 = lane & 15, g = lane >> 4;
    LAS float* Ot = (LAS float*)lds;
    const int zrow = tid >> 3, zpc = tid & 7; const size_t grow = (size_t)b * SEQ + n * 64 + zrow;
    f32x4 vn[4];
#pragma unroll
    for (int mt = 0; mt < 4; ++mt) { f32x4 uc; uc[0] = __uint_as_float(R.un[mt].x << 16); uc[1] = __uint_as_float(R.un[mt].x & 0xffff0000u); uc[2] = __uint_as_float(R.un[mt].y << 16); uc[3] = __uint_as_float(R.un[mt].y & 0xffff0000u);
        f32x4 a = {0.f, 0.f, 0.f, 0.f}; a = MFMA16(R.aw[mt][0], R.Sb[0], a); a = MFMA16(R.aw[mt][1], R.Sb[1], a); vn[mt] = uc - a; }
    bf16x8 vb[2]; vb[0] = pack8(vn[0], vn[1]); vb[1] = pack8(vn[2], vn[3]);
#pragma unroll
    for (int mi = 0; mi < 2; ++mi) { f32x4 a = {0.f, 0.f, 0.f, 0.f}; a = MFMA16(R.aq[mi][0], R.Sb[0], a); a = MFMA16(R.aq[mi][1], R.Sb[1], a); a = MFMA16(R.ak[mi][0], vb[0], a); a = MFMA16(R.ak[mi][1], vb[1], a);
#pragma unroll
        for (int i = 0; i < 4; ++i) Ot[(16 * (2 * hm + mi) + 4 * g + i) * 65 + 16 * sl + n16] = a[i]; }
    __syncthreads();
    {   float v[8]; float ss = 0.f;
#pragma unroll
        for (int t = 0; t < 8; ++t) { v[t] = Ot[zrow * 65 + 8 * zpc + t]; ss += v[t] * v[t]; }
        ss += __shfl_xor(ss, 1); ss += __shfl_xor(ss, 2); ss += __shfl_xor(ss, 4);
        const float rstd = rsqrtf(ss * (1.f / 64.f) + EPS); const LAS float* ng = Ot + 4160 + 8 * zpc;
        const unsigned zw[4] = {R.zv.x, R.zv.y, R.zv.z, R.zv.w}; v4u o;
        unsigned ow[4];
#pragma unroll
        for (int c = 0; c < 4; ++c) { const float za = __uint_as_float(zw[c] << 16), zb = __uint_as_float(zw[c] & 0xffff0000u);
            ow[c] = pk2(v[2 * c] * rstd * ng[2 * c] * silu_f(za), v[2 * c + 1] * rstd * ng[2 * c + 1] * silu_f(zb)); }
        o.x = ow[0]; o.y = ow[1]; o.z = ow[2]; o.w = ow[3];
        *(v4u*)(Y + grow * DM + 640 + h * 64 + 8 * zpc) = o; }
    __syncthreads();
}
__device__ __forceinline__ void gdn_out_phase(const Params& p, int l, int it0, int step, LAS unsigned char* lds, int tid, int wave, int lane) {
    OphRegs RA, RB;
    if (tid < 64) ((LAS float*)lds)[4160 + tid] = p.in[17][l * 64 + tid];
    if (it0 < 1536) gdn_out_load(p, it0, RA, tid, wave, lane);
    for (int it = it0; it < 1536; it += 2 * step) {
        const int it1 = it + step, it2 = it + 2 * step;
        if (it1 < 1536) gdn_out_load(p, it1, RB, tid, wave, lane);
        gdn_out_compute(p, l, it, RA, lds, tid, wave, lane);
        if (it1 < 1536) {
            if (it2 < 1536) gdn_out_load(p, it2, RA, tid, wave, lane);
            gdn_out_compute(p, l, it1, RB, lds, tid, wave, lane);
        }
    }
}

constexpr float MOBA_C2 = 0.125f * 1.4426950408889634f;
#ifndef MB_NC
#define MB_NC 8
#endif
constexpr int MB_PR = 68;
constexpr int MB_P = 0, MB_LSEL = 104448, MB_MSH = 107520, MB_CNT = 108544, MB_TST = 108672, MB_LIST = 108928, MB_QS = 124800, MB_KMAX = 161664;
template <bool OWN>
__device__ __forceinline__ void moba_task(const bf16* KT, const bf16* VT, bf16* Y, int b, int h, int bh, int qb, int j, int gi, int nv, int nsel, int wave, int lane, LAS unsigned char* lds) {
    int ln_ = lane; asm volatile("" : "+v"(ln_));
    const int n = ln_ & 15, g = ln_ >> 4;
    const LAS float* msh = (const LAS float*)(lds + MB_MSH); LAS float* lsel = (LAS float*)(lds + MB_LSEL); const LAS unsigned short* list = (const LAS unsigned short*)(lds + MB_LIST);
    const LAS unsigned char* Qs = lds + MB_QS;
    int ql[2], sl[2]; bool valid[2]; float msl[2];
#pragma unroll
    for (int nt = 0; nt < 2; ++nt) {
        const int slot = 16 * nt + n;
        if (OWN) { ql[nt] = 32 * wave + slot; sl[nt] = 0; valid[nt] = true; }
        else { valid[nt] = slot < nv; const unsigned e = list[j * 256 + 32 * gi + (valid[nt] ? slot : 0)]; ql[nt] = e & 255; sl[nt] = e >> 8; }
        msl[nt] = msh[ql[nt]];
    }
    const int nch = OWN ? (wave + 1) : 8;
    const bf16* kbase = KT + ((size_t)bh * 256 + j * 8) * 2048 + g * 128 + n * 8;
    const bf16* vbase = VT + ((size_t)bh * 256 + j * 8) * 2048 + g * 128 + n * 8;
    f32x4 O[4][2]; float ls[2] = {0.f, 0.f};
#pragma unroll
    for (int dt = 0; dt < 4; ++dt) { O[dt][0] = (f32x4){0.f, 0.f, 0.f, 0.f}; O[dt][1] = O[dt][0]; }
#pragma unroll 1
    for (int c0 = 0; c0 < nch; c0 += MB_NC) {
        bf16x8 pb[MB_NC][2];
        {   bf16x8 kf[MB_NC][2][2];
#pragma unroll
            for (int cc = 0; cc < MB_NC; ++cc) { const int c_ = (c0 + cc) < nch ? (c0 + cc) : nch - 1;
#pragma unroll
                for (int tt = 0; tt < 2; ++tt) { const bf16* kp_ = kbase + (size_t)c_ * 2048 + tt * 1024; kf[cc][tt][0] = *(const bf16x8*)kp_; kf[cc][tt][1] = *(const bf16x8*)(kp_ + 512); } }
            bf16x8 qf[2][2];
#pragma unroll
            for (int nt = 0; nt < 2; ++nt) { qf[nt][0] = *(const LAS bf16x8*)(Qs + ql[nt] * 144 + g * 16); qf[nt][1] = *(const LAS bf16x8*)(Qs + ql[nt] * 144 + 64 + g * 16); }
#pragma unroll
            for (int cc = 0; cc < MB_NC; ++cc) {
                const int kc = c0 + cc;
#pragma unroll
                for (int nt = 0; nt < 2; ++nt) {
                    f32x4 s[2];
#pragma unroll
                    for (int tt = 0; tt < 2; ++tt) { f32x4 a = {-msl[nt], -msl[nt], -msl[nt], -msl[nt]}; a = MFMA16(kf[cc][tt][0], qf[nt][0], a); a = MFMA16(kf[cc][tt][1], qf[nt][1], a); s[tt] = a; }
#pragma unroll
                    for (int tt = 0; tt < 2; ++tt)
#pragma unroll
                        for (int i = 0; i < 4; ++i) { float pv = __builtin_amdgcn_exp2f(s[tt][i]);
                            if (OWN) { if (32 * kc + 8 * g + 4 * tt + i > ql[nt]) pv = 0.f; }
                            if (OWN) { if (kc >= nch) pv = 0.f; }
                            s[tt][i] = pv; ls[nt] += pv; }
                    pb[cc][nt] = pack8(s[0], s[1]);
                }
            }
        }
        {   bf16x8 vf[MB_NC][4];
#pragma unroll
            for (int cc = 0; cc < MB_NC; ++cc) { const int c_ = (c0 + cc) < nch ? (c0 + cc) : nch - 1;
#pragma unroll
                for (int dt = 0; dt < 4; ++dt) vf[cc][dt] = *(const bf16x8*)(vbase + (size_t)c_ * 2048 + dt * 512); }
#pragma unroll
            for (int cc = 0; cc < MB_NC; ++cc)
#pragma unroll
                for (int dt = 0; dt < 4; ++dt) { O[dt][0] = MFMA16(vf[cc][dt], pb[cc][0], O[dt][0]); O[dt][1] = MFMA16(vf[cc][dt], pb[cc][1], O[dt][1]); }
        }
    }
#pragma unroll
    for (int nt = 0; nt < 2; ++nt) {
        float l = ls[nt]; l += __shfl_xor(l, 16); l += __shfl_xor(l, 32);
        if (OWN) {
            for (int sidx = 0; sidx < nsel; ++sidx) {
                l += lsel[sidx * 256 + ql[nt]];
#pragma unroll
                for (int dt = 0; dt < 4; ++dt) { const v2u w = *(const LAS v2u*)(lds + MB_P + ((sidx * 256 + ql[nt]) * MB_PR + 16 * dt + 4 * g) * 2);
                    O[dt][nt][0] += __uint_as_float(w.x << 16); O[dt][nt][1] += __uint_as_float(w.x & 0xffff0000u); O[dt][nt][2] += __uint_as_float(w.y << 16); O[dt][nt][3] += __uint_as_float(w.y & 0xffff0000u); }
            }
            const float inv = 1.f / l;
            bf16* yp = Y + ((size_t)b * SEQ + qb * 256 + ql[nt]) * DM + 256 + h * 64 + 4 * g;
#pragma unroll
            for (int dt = 0; dt < 4; ++dt) { v2u w; w.x = pk2(O[dt][nt][0] * inv, O[dt][nt][1] * inv); w.y = pk2(O[dt][nt][2] * inv, O[dt][nt][3] * inv); *(v2u*)(yp + 16 * dt) = w; }
        } else if (valid[nt]) {
#pragma unroll
            for (int dt = 0; dt < 4; ++dt) { v2u w; w.x = pk2(O[dt][nt][0], O[dt][nt][1]); w.y = pk2(O[dt][nt][2], O[dt][nt][3]);
                *(LAS v2u*)(lds + MB_P + ((sl[nt] * 256 + ql[nt]) * MB_PR + 16 * dt + 4 * g) * 2) = w; }
            if (g == 0) lsel[sl[nt] * 256 + ql[nt]] = l;
        }
    }
}
__device__ __forceinline__ void moba_unit(const Params& p, int bh, int qb, LAS unsigned char* lds, int tid, int wave, int lane, int mvar = 0) {
    const bf16* U = (const bf16*)(p.ws + WS_U); const bf16* VT = (const bf16*)(p.ws + WS_VT); const bf16* KT = (const bf16*)(p.ws + WS_KT); bf16* Y = (bf16*)(p.ws + WS_Y);
    const int b = bh / 6, h = bh % 6;
    LAS float* msh = (LAS float*)(lds + MB_MSH); LAS float* kms = (LAS float*)(lds + MB_P);
    LAS int* cnt = (LAS int*)(lds + MB_CNT); LAS int* tstart = (LAS int*)(lds + MB_TST); LAS unsigned short* list = (LAS unsigned short*)(lds + MB_LIST); LAS unsigned char* Qs = lds + MB_QS;
    const float* kmean = (const float*)(p.ws + WS_KMEAN) + (size_t)bh * 32 * 64; const float* knmax = (const float*)(p.ws + WS_KNMAX) + bh * 32;
    const size_t qrow0 = (size_t)b * SEQ + qb * 256;
    {   v4u qv4[4];
#pragma unroll
        for (int i = 0; i < 4; ++i) { const int pi = tid + 512 * i; qv4[i] = *(const v4u*)(U + (qrow0 + (pi >> 3)) * DINP + MQ0 + h * 64 + 8 * (pi & 7)); }
        float km4[4];
#pragma unroll
        for (int i = 0; i < 4; ++i) { const int idx = tid + 512 * i; km4[i] = (idx < qb * 64) ? kmean[idx] : 0.f; }
        float kn = (tid < 32 && tid <= qb) ? knmax[tid] : 0.f;
        if (tid < 32) cnt[tid] = 0;
#pragma unroll
        for (int i = 0; i < 4; ++i) { const int idx = tid + 512 * i; if (idx < 31 * 64) kms[idx] = km4[i]; }
#pragma unroll
        for (int i = 0; i < 4; ++i) { const int pi = tid + 512 * i; const unsigned qw[4] = {qv4[i].x, qv4[i].y, qv4[i].z, qv4[i].w}; v4u o;
            unsigned ow[4];
#pragma unroll
            for (int t = 0; t < 4; ++t) ow[t] = pk2(__uint_as_float(qw[t] << 16) * MOBA_C2, __uint_as_float(qw[t] & 0xffff0000u) * MOBA_C2);
            o.x = ow[0]; o.y = ow[1]; o.z = ow[2]; o.w = ow[3]; *(LAS v4u*)(Qs + (pi >> 3) * 144 + (pi & 7) * 16) = o; }
        if (tid < 64) {
#pragma unroll
            for (int o = 1; o < 64; o <<= 1) kn = fmaxf(kn, __shfl_xor(kn, o));
            if (tid == 0) *(LAS float*)(lds + MB_KMAX) = kn; }
    }
    __syncthreads();
    const float kmax = *(const LAS float*)(lds + MB_KMAX);
    {
        const int q = tid >> 1, hf = tid & 1;
        float qv[64]; float qn2 = 0.f;
#pragma unroll
        for (int c8 = 0; c8 < 8; ++c8) { const v4u w = *(const LAS v4u*)(Qs + q * 144 + c8 * 16);
            qv[8 * c8 + 0] = __uint_as_float(w.x << 16); qv[8 * c8 + 1] = __uint_as_float(w.x & 0xffff0000u); qv[8 * c8 + 2] = __uint_as_float(w.y << 16); qv[8 * c8 + 3] = __uint_as_float(w.y & 0xffff0000u);
            qv[8 * c8 + 4] = __uint_as_float(w.z << 16); qv[8 * c8 + 5] = __uint_as_float(w.z & 0xffff0000u); qv[8 * c8 + 6] = __uint_as_float(w.w << 16); qv[8 * c8 + 7] = __uint_as_float(w.w & 0xffff0000u); }
#pragma unroll
        for (int d = 0; d < 64; ++d) qn2 += qv[d] * qv[d];
        float v1 = -INFINITY, v2 = -INFINITY, v3 = -INFINITY; int i1 = -1, i2 = -1, i3 = -1;
        for (int jj = hf; jj < qb; jj += 2) { float sc = 0.f; const LAS f32x4* kr = (const LAS f32x4*)(kms + jj * 64);
#pragma unroll
            for (int d4 = 0; d4 < 16; ++d4) { const f32x4 kv = kr[d4]; sc += (qv[4 * d4] * kv[0] + qv[4 * d4 + 1] * kv[1]) + (qv[4 * d4 + 2] * kv[2] + qv[4 * d4 + 3] * kv[3]); }
            if (sc > v1) { v3 = v2; i3 = i2; v2 = v1; i2 = i1; v1 = sc; i1 = jj; } else if (sc > v2) { v3 = v2; i3 = i2; v2 = sc; i2 = jj; } else if (sc > v3) { v3 = sc; i3 = jj; } }
        float pvv[3]; int pii[3];
        pvv[0] = __shfl_xor(v1, 1); pvv[1] = __shfl_xor(v2, 1); pvv[2] = __shfl_xor(v3, 1); pii[0] = __shfl_xor(i1, 1); pii[1] = __shfl_xor(i2, 1); pii[2] = __shfl_xor(i3, 1);
#pragma unroll
        for (int t = 0; t < 3; ++t) { const float sc = pvv[t]; const int jj = pii[t];
            if (jj >= 0) {
                if (sc > v1 || (sc == v1 && jj < i1)) { v3 = v2; i3 = i2; v2 = v1; i2 = i1; v1 = sc; i1 = jj; }
                else if (sc > v2 || (sc == v2 && jj < i2)) { v3 = v2; i3 = i2; v2 = sc; i2 = jj; }
                else if (sc > v3 || (sc == v3 && jj < i3)) { v3 = sc; i3 = jj; } } }
        if (hf == 0) {
            if (i1 >= 0) { const int pos = __hip_atomic_fetch_add(&cnt[i1], 1, __ATOMIC_RELAXED, __HIP_MEMORY_SCOPE_WORKGROUP); list[i1 * 256 + pos] = (unsigned short)q; }
            if (i2 >= 0) { const int pos = __hip_atomic_fetch_add(&cnt[i2], 1, __ATOMIC_RELAXED, __HIP_MEMORY_SCOPE_WORKGROUP); list[i2 * 256 + pos] = (unsigned short)(q | 256); }
            if (i3 >= 0) { const int pos = __hip_atomic_fetch_add(&cnt[i3], 1, __ATOMIC_RELAXED, __HIP_MEMORY_SCOPE_WORKGROUP); list[i3 * 256 + pos] = (unsigned short)(q | 512); }
            msh[q] = sqrtf(qn2) * kmax;
        }
    }
    __syncthreads();
    LAS unsigned short* ttab = (LAS unsigned short*)tstart;
    if (tid < 64) { const int ng = (tid < qb) ? ((cnt[tid] + 31) >> 5) : 0; int inc = ng;
#pragma unroll
        for (int o = 1; o < 64; o <<= 1) { const int v = __shfl_up(inc, o); if (lane >= o) inc += v; }
        const int st = inc - ng;
        for (int gi = 0; gi < ng; ++gi) ttab[st + gi] = (unsigned short)(tid | (gi << 8));
        if (tid == 63) ttab[127] = (unsigned short)inc; }
    __syncthreads();
    const int ntask = ttab[127];
    for (int t = wave; t < (mvar == 1 ? 0 : ntask); t += 8) {
        const unsigned te = ttab[t]; const int jj = te & 255, gi = te >> 8; int nv = cnt[jj] - 32 * gi; nv = nv > 32 ? 32 : nv;
        moba_task<false>(KT, VT, Y, b, h, bh, qb, jj, gi, nv, 0, wave, lane, lds);
    }
    __syncthreads();
    moba_task<true>(KT, VT, Y, b, h, bh, qb, qb, 0, 32, qb < 3 ? qb : 3, wave, lane, lds);
    __syncthreads();
}

__device__ __forceinline__ void phase_final(const Params& p, int wave, int lane) {
    const int gw = blockIdx.x * 8 + wave, NGW = gridDim.x * 8; const float* rs = (const float*)(p.ws + WS_RS) + 6 * MTOK; const float* fg = p.in[23];
    f32x4 gv[4];
#pragma unroll
    for (int j = 0; j < 4; ++j) gv[j] = *((const f32x4*)fg + lane + 64 * j);
    for (int row0 = gw; row0 < MTOK; row0 += 8 * NGW) {
        f32x4 v[8][4]; float rstd[8];
#pragma unroll
        for (int rr = 0; rr < 8; ++rr) { const int row = (row0 + rr * NGW) < MTOK ? (row0 + rr * NGW) : row0; rstd[rr] = rsqrtf(rs[row] * (1.f / DM) + EPS); const f32x4* o = (const f32x4*)(p.out + (size_t)row * DM) + lane;
#pragma unroll
            for (int j = 0; j < 4; ++j) v[rr][j] = o[64 * j]; }
#pragma unroll
        for (int rr = 0; rr < 8; ++rr) { const int row = row0 + rr * NGW; if (row < MTOK) { f32x4* o = (f32x4*)(p.out + (size_t)row * DM) + lane;
#pragma unroll
            for (int j = 0; j < 4; ++j) o[64 * j] = v[rr][j] * rstd[rr] * gv[j]; } }
    }
}

__global__ void __launch_bounds__(512) fwd(Params p) {
    extern __shared__ __attribute__((aligned(16))) unsigned char lds_raw[];
    LAS unsigned char* lds = (LAS unsigned char*)lds_raw;
    cg::grid_group grid = cg::this_grid();
    const int G = gridDim.x, bx = blockIdx.x;
    if (threadIdx.x < 16) ((volatile LAS unsigned*)(lds + LDS_BARST))[threadIdx.x] = 0u;
    __syncthreads();
    XcdBarrier xbar = xcd_barrier_post((unsigned*)(p.ws + WS_BAR), (volatile LAS unsigned*)(lds + LDS_BARST));
#define GRID_SYNC() do { if (MK_MULTI) {} else if (first_sync) { grid.sync(); first_sync = false; } else xcd_barrier(xbar); } while (0)
    bool first_sync = true;
    bool rep_done = false; (void)rep_done;
#ifdef PROBE_EXTRA_SYNCS
    for (int i = 0; i < PROBE_EXTRA_SYNCS; ++i) GRID_SYNC();
#endif
#ifndef PROBE_SKIP
#define PROBE_SKIP 0
#endif
    for (int ph = p.ph_lo; ph < p.ph_hi; ++ph) {
        if (ph == 11 && G == 256) continue;
        int tid = threadIdx.x; asm volatile("" : "+v"(tid));
        const int lane = tid & 63, wave = __builtin_amdgcn_readfirstlane(tid >> 6);
        unsigned char* ws = p.ws; asm volatile("" : "+s"(ws));
        if (ph == 0) {
#ifndef NO_PRE
 phase_pre(p, tid, wave, lane);
#endif
}
        else if (ph == NPH - 1) phase_final(p, wave, lane);
        else {
            const int l = (ph - 1) / 10, s0_ = (ph - 1) % 10; const int s = s0_ < 6 ? s0_ : (s0_ == 6 ? 99 : s0_ - 1);
            float* rs = (float*)(ws + WS_RS); const float* mod = (const float*)(ws + WS_MOD) + (l * 2) * 9216; const float* bias = (const float*)(ws + WS_BIAS) + l * BIAS_L;
            unsigned char* wb = ws + WS_W;
            if (s == 0) {
#ifndef NO_CVT
 phase_cvt(p, l, lds, wave, lane, 0, (G != 256) ? 5312 : (l == 0 ? 2048 : 0), bx * 8 + wave, G * 8);
#endif
}
            else if (s == 1 || s == 7) {
                pg8::Gemm g{(const bf16*)(ws + WS_XB), (const bf16*)(wb + (s == 1 ? W_1GU : W_2GU)), MTOK, NGU, DM, (size_t)NGU * DM * 2};
                pg8::StaticOrder S; S.init(MTOK, NGU, G, bx);
                EpiGU E{(bf16*)(ws + WS_U), rs + (3 * l + (s == 1 ? 0 : 2)) * MTOK, bias + (s == 1 ? 0 : 2 * NGU + 2 * DINP)};
#ifndef NO_GU
                pg8::gemm_phase<EpiGU, pg8::StaticOrder, true, true>(lds, g, S, E, tid);
                if (s == 1 && G == 256 && bx >= 128) { __syncthreads(); phase_cvt(p, l, lds, wave, lane, l == 0 ? 2048 : 2112, 5312, (bx - 128) * 8 + wave, 128 * 8); }
#endif
            } else if (s == 2 || s == 6 || s == 8) {
                const int K = (s == 6) ? DM : FF;
                pg8::Gemm g{(const bf16*)(ws + (s == 6 ? WS_Y : WS_U)), (const bf16*)(wb + (s == 2 ? W_D1 : (s == 6 ? W_OUT : W_D2))), MTOK, DM, K, 0};
                pg8::StaticOrder S; S.init(MTOK, DM, G, bx);
                EpiRes E{(l == 0 && s == 2) ? p.in[0] : (const float*)p.out, p.out, (bf16*)(ws + WS_XB), rs + (3 * l + (s == 2 ? 1 : (s == 6 ? 2 : 3))) * MTOK, mod + (s == 2 ? 2048 : (s == 6 ? 5120 : 8192)), (s == 6) ? 1.0f : 0.5f};
#ifndef NO_RES
                pg8::gemm_phase<EpiRes, pg8::StaticOrder, true, true>(lds, g, S, E, tid);
#endif
            } else if (s == 3) {
                pg8::Gemm g{(const bf16*)(ws + WS_XB), (const bf16*)(wb + W_IN), MTOK, DINP, DM, (size_t)DINP * DM * 2};
                pg8::StaticOrder S; S.init(MTOK, DINP, G, bx);
                EpiIn E{(bf16*)(ws + WS_U), rs + (3 * l + 1) * MTOK, bias + 2 * NGU, (const float*)(ws + WS_ROPE)};
#ifndef NO_IN
                pg8::gemm_phase<EpiIn, pg8::StaticOrder, true, true>(lds, g, S, E, tid);
                if (l + 1 < 2 && G == 256 && bx >= 64) { __syncthreads(); phase_cvt(p, l + 1, lds, wave, lane, 0, 2112, (bx - 64) * 8 + wave, 192 * 8); }
#endif
            } else if (s == 4) {
#ifndef NO_GPREP
#ifdef PROBE_GPREP_VAR
                if (!rep_done) { for (int it = bx; it < 1536; it += G) gdnprep_item(p, l, it, lds, tid, lane, PROBE_GPREP_VAR); } else
#endif
                if (!(rep_done && (PROBE_SKIP & 1))) for (int it = bx; it < 1536; it += G) gdnprep_item(p, l, it, lds, tid, lane);
#endif
#ifndef NO_MPREP
#ifdef PROBE_GPREP_VAR
                if (rep_done)
#endif
                if (!(rep_done && (PROBE_SKIP & 4))) for (int it = bx; it < 384; it += G) mobaprep_item(p, it, lds, tid);
#endif
            } else if (s == 99) {
                gdn_out_phase(p, l, bx, G, lds, tid, wave, lane);
            } else if (s == 5) {
                int cv0 = 0, cvn = 0, cvs = 1;
                if (bx < 12) {
#ifndef NO_SCAN
#ifdef PROBE_SCAN_VAR
 if (!rep_done) gdn_scan<PROBE_SCAN_VAR>(p, l, bx, lds, tid, wave, lane); else
#endif
#ifdef PROBE_MOBA_VAR
 if (rep_done)
#endif
 if (!(rep_done && (PROBE_SKIP & 8))) gdn_scan<0>(p, l, bx, lds, tid, wave, lane);
#endif
}
                else if (G == 256) {
                    const int x = bx & 7, first = (x < 4) ? x + 16 : x + 8, nblk = (256 - first + 7) >> 3, lidx = (bx - first) >> 3;
                    unsigned ulist = 0u; int nu = 0;
                    if (lidx < 32) { ulist |= (unsigned)(x * 32 + 31 - lidx) << (10 * nu); ++nu; }
                    { const int i = nblk - 1 - lidx; if (i >= 0 && i < 16) { ulist |= (unsigned)((8 + (x >> 1)) * 32 + 31 - 2 * i - (x & 1)) << (10 * nu); ++nu; } }
                    { const int k = nblk + (nblk - 17 - lidx); if (lidx <= nblk - 17 && k >= nblk && k < 32) { ulist |= (unsigned)(x * 32 + 31 - k) << (10 * nu); ++nu; } }
                    ulist = __builtin_amdgcn_readfirstlane(ulist); nu = __builtin_amdgcn_readfirstlane(nu);
                    for (int ui = 0; ui < nu; ++ui) {
                        const int uu = (ulist >> (10 * ui)) & 1023, cbh = uu >> 5, cqb = uu & 31;
#ifndef NO_MOBA
#ifdef PROBE_MOBA_VAR
                        if (!rep_done) moba_unit(p, cbh, cqb, lds, tid, wave, lane, PROBE_MOBA_VAR); else
#endif
                        if (!(rep_done && (PROBE_SKIP & 16))) moba_unit(p, cbh, cqb, lds, tid, wave, lane);
#endif
                    }
                    {   const int ns = nblk - 18;
                        if (lidx < ns) { cv0 = 32 * x + 2 * lidx; cvn = 2; }
                        else { const int r = 2 * ns + (lidx - (nblk - 16)); if (lidx >= nblk - 16 && r < 32) { cv0 = 32 * x + r; cvn = 1; } } }
                } else { for (int it = bx - 12; it < 384; it += G - 12) moba_unit(p, it % 12, 31 - it / 12, lds, tid, wave, lane);
                    cv0 = bx - 12; cvs = G - 12; cvn = (cv0 < 256) ? (256 - cv0 + cvs - 1) / cvs : 0; }
                for (int k = 0; k < cvn; ++k) conv_item(p, l, cv0 + k * cvs, (LAS float*)lds, tid, wave, lane);
            }
        }
#if defined(PROBE_REP_S)
        if (ph > 0 && ph < NPH - 1 && (ph - 1) % 10 == PROBE_REP_S && !rep_done) { rep_done = true; GRID_SYNC(); --ph; continue; }
        rep_done = false;
#endif
        if (ph + 1 < p.ph_hi) GRID_SYNC();
    }
}

extern "C" void kernel_launch(void* const* d_in, const int* in_sizes, int n_in, void* d_out, int out_size, void* d_ws, size_t ws_size, hipStream_t stream) {
    static int grid = 0;
    if (grid == 0) {
        if (n_in != 24 || out_size != MTOK * DM || ws_size < WS_END) { fprintf(stderr, "kernel_launch: unexpected shapes (n_in %d out %d ws %zu)\n", n_in, out_size, ws_size); grid = -1; return; }
        int dev = 0, cus = 0, per_cu = 0;
        hipGetDevice(&dev); hipDeviceGetAttribute(&cus, hipDeviceAttributeMultiprocessorCount, dev);
        hipFuncSetAttribute((const void*)fwd, hipFuncAttributeMaxDynamicSharedMemorySize, LDS_BYTES);
        hipOccupancyMaxActiveBlocksPerMultiprocessor(&per_cu, (const void*)fwd, 512, LDS_BYTES);
        if (per_cu < 1) per_cu = 1;
        grid = cus * per_cu; if (grid > 256) grid = 256;
        (void)hipGetLastError();
    }
    if (grid < 0) return;
    hipMemsetAsync(d_ws, 0, CTL_ZERO, stream);
    Params p{};
    for (int i = 0; i < 24; ++i) p.in[i] = (const float*)d_in[i];
    p.out = (float*)d_out; p.ws = (unsigned char*)d_ws;
#if MK_MULTI
    for (int ph = 0; ph < NPH; ++ph) { p.ph_lo = ph; p.ph_hi = ph + 1; hipLaunchKernelGGL(fwd, dim3(grid), dim3(512), LDS_BYTES, stream, p); }
#else
    p.ph_lo = 0; p.ph_hi = NPH;
    void* args[] = {&p};
    hipError_t e = hipLaunchCooperativeKernel((const void*)fwd, dim3(grid), dim3(512), args, LDS_BYTES, stream);
    if (e != hipSuccess) fprintf(stderr, "cooperative launch failed: %s (grid %d)\n", hipGetErrorString(e), grid);
#endif
}
```

```cpp
#include <hip/hip_runtime.h>
#include <hip/hip_cooperative_groups.h>
#include <cstdio>
#include <cstdint>
#include <cmath>
namespace cg = cooperative_groups;
#define MB_NC 4
namespace pg8 {
#define PG8_LAS __attribute__((address_space(3)))
typedef unsigned short bf16_t;
typedef short bf16x8 __attribute__((ext_vector_type(8)));
typedef float f32x4 __attribute__((ext_vector_type(4)));
typedef unsigned u32x4 __attribute__((ext_vector_type(4)));
constexpr int BM = 256, BK = 64, HALF = 128, HTB = HALF * BK * 2  , STAGE_BYTES = 8 * HTB, NXCD = 8, WGM = 8;

__host__ __device__ __forceinline__ int lds_byte(int r, int c) { const int st = (r >> 4) * 2 + (c >> 5), rr = r & 15, cc = c & 31, ob = rr * 64 + cc * 2; return st * 1024 + (ob ^ (((ob >> 9) & 1) << 5)); }
__host__ __device__ __forceinline__ void stage_rc(int b, int& R, int& C) { const int st = b / 1024, sb = b % 1024, swz = sb ^ (((sb >> 9) & 1) << 5); R = (st >> 1) * 16 + swz / 64; C = (st & 1) * 32 + (swz % 64) / 2; }
__host__ __device__ __forceinline__ int perm32(int rho) { const int n = rho >> 4, i = rho & 15; return 8 * (i >> 2) + 4 * n + (i & 3); }

struct Unit { int pm, pn; };
struct Gemm { const bf16_t* A; const bf16_t* Bt; int M, N, K; size_t bstride; };

struct StaticOrder {
    int nM, nN, nwg, G, c;
    __host__ __device__ void init(int M, int N, int G_, int c_) { nM = M / BM; nN = N / BM; nwg = nM * nN; G = G_; c = c_; }
    __host__ __device__ bool next(int i, Unit& u) const {
        const long L = (long)i * G + c; if (L >= nwg) return false;
        int wgid = (int)L; { const int q = nwg / NXCD, r = nwg % NXCD, xcd = wgid % NXCD, off = wgid / NXCD; wgid = (xcd < r ? xcd * (q + 1) : r * (q + 1) + (xcd - r) * q) + off; }
        const int nig = WGM * nN, gid = wgid / nig, fm = gid * WGM, gsz = (nM - fm) < WGM ? (nM - fm) : WGM;
        u.pm = fm + ((wgid % nig) % gsz); u.pn = (wgid % nig) / gsz; return true;
    }
    __device__ __forceinline__ void a_ready(const Unit&) const {}
    __device__ __forceinline__ void done(const Unit&) const {}
};

__device__ __forceinline__ unsigned cvt_pk_bf16(float lo, float hi) { unsigned r; asm volatile("v_cvt_pk_bf16_f32 %0, %1, %2" : "=v"(r) : "v"(lo), "v"(hi)); return r; }
typedef float f32x2 __attribute__((ext_vector_type(2)));
typedef float f32x2 __attribute__((ext_vector_type(2)));
template <class Epi, class Sched, bool ALIGN_EPI = false, bool SP2 = false>
__device__ __forceinline__ void gemm_phase(PG8_LAS unsigned char* lds, const Gemm g, const Sched& S, const Epi& E, const int tid_in) {
    const int tid = tid_in, wid = __builtin_amdgcn_readfirstlane(tid >> 6), lane = tid & 63, wr = wid >> 2, wc = wid & 3, fr = lane & 15, fq = lane >> 4;
    const int K = g.K, nt = K / BK;
    unsigned voffA[2], voffB[2];
#pragma unroll
    for (int i = 0; i < 2; ++i) { int R, C; stage_rc(tid * 16 + i * 8192, R, C); const int Rb = Epi::PERM ? ((R & ~31) + perm32(R & 31)) : R;
        voffA[i] = (unsigned)(R * K + C) * 2u; voffB[i] = (unsigned)(Rb * K + C) * 2u; }
    const size_t kstep = (size_t)(BK * 2);
    const size_t hstep = (size_t)HALF * K * 2;
    const size_t tstep = 2 * hstep;
    const unsigned ldsw = (unsigned)wid * 1024u;
    const int aoff = lds_byte(wr * 64 + fr, fq * 8), boff = lds_byte(wc * 32 + fr, fq * 8);
#define PG8_SA(b, h) (((b) * 2 + (h)) * HTB)
#define PG8_SB(b, h) ((4 + (b) * 2 + (h)) * HTB)
#define PG8_STAGE(bufoff, gbase, voff) do { _Pragma("unroll") for (int _i = 0; _i < 2; ++_i) \
        __builtin_amdgcn_global_load_lds((const unsigned*)((const char*)(gbase) + (voff)[_i]), (PG8_LAS unsigned*)(lds + (bufoff) + ldsw + _i * 8192), 16, 0, 0); } while (0)
#define PG8_LDA(dst, b, h) do { _Pragma("unroll") for (int m = 0; m < 4; ++m) _Pragma("unroll") for (int k = 0; k < 2; ++k) dst[m][k] = *(const PG8_LAS bf16x8*)(lds + PG8_SA(b, h) + aoff + m * 2048 + k * 1024); } while (0)
#define PG8_LDB(dst, b, h) do { _Pragma("unroll") for (int n = 0; n < 2; ++n) _Pragma("unroll") for (int k = 0; k < 2; ++k) dst[n][k] = *(const PG8_LAS bf16x8*)(lds + PG8_SB(b, h) + boff + n * 2048 + k * 1024); } while (0)
#define PG8_MMA(ai, bj, At, Bt) do { __builtin_amdgcn_s_setprio(1); _Pragma("unroll") for (int m = 0; m < 4; ++m) _Pragma("unroll") for (int n = 0; n < 2; ++n) _Pragma("unroll") for (int k = 0; k < 2; ++k) \
        acc[ai][bj][m][n] = __builtin_amdgcn_mfma_f32_16x16x32_bf16(Bt[n][k], At[m][k], acc[ai][bj][m][n], 0, 0, 0); __builtin_amdgcn_s_setprio(0); } while (0)
#define PG8_WAIT_V(n) asm volatile("s_waitcnt vmcnt(" #n ")" ::: "memory")
#define PG8_WAIT_L(n) asm volatile("s_waitcnt lgkmcnt(" #n ")" ::: "memory")
#define PG8_BAR __builtin_amdgcn_s_barrier()
#define PG8_SCHED __builtin_amdgcn_sched_barrier(0)
    Unit cur, nxt; int ui = 0;
    if (!S.next(0, cur)) return;
    f32x4 acc[2][2][4][2];
#pragma unroll
    for (int a = 0; a < 2; ++a)
#pragma unroll
        for (int b = 0; b < 2; ++b)
#pragma unroll
            for (int m = 0; m < 4; ++m)
#pragma unroll
                for (int n = 0; n < 2; ++n) acc[a][b][m][n] = (f32x4){0.f, 0.f, 0.f, 0.f};
    bf16x8 At[4][2], B0[2][2], B1[2][2];
    const char* cA = (const char*)g.A + (size_t)cur.pm * tstep; const char* cB = (const char*)g.Bt + (size_t)cur.pn * tstep + (size_t)(cur.pm >> 5) * g.bstride;
    S.a_ready(cur);
    if constexpr (SP2) {
        PG8_STAGE(PG8_SB(0, 0), cB, voffB); PG8_STAGE(PG8_SB(0, 1), cB + hstep, voffB); PG8_STAGE(PG8_SA(0, 0), cA, voffA); PG8_STAGE(PG8_SA(0, 1), cA + hstep, voffA);
        if (wr == 1) PG8_BAR;
        PG8_WAIT_V(2); PG8_BAR;
        PG8_STAGE(PG8_SB(1, 0), cB + kstep, voffB); PG8_STAGE(PG8_SA(1, 0), cA + kstep, voffA); PG8_STAGE(PG8_SB(1, 1), cB + hstep + kstep, voffB);
        PG8_WAIT_V(6); PG8_BAR;
    } else {
        PG8_STAGE(PG8_SB(0, 0), cB, voffB); PG8_STAGE(PG8_SA(0, 0), cA, voffA); PG8_STAGE(PG8_SB(0, 1), cB + hstep, voffB); PG8_STAGE(PG8_SA(0, 1), cA + hstep, voffA);
        if (wr == 1) PG8_BAR;
        PG8_WAIT_V(4); PG8_BAR;
        PG8_STAGE(PG8_SB(1, 0), cB + kstep, voffB); PG8_STAGE(PG8_SA(1, 0), cA + kstep, voffA); PG8_STAGE(PG8_SB(1, 1), cB + hstep + kstep, voffB);
        PG8_WAIT_V(6); PG8_BAR;
    }
    for (;;) {
        const bool has_next = S.next(ui + 1, nxt);
        const char* nA = has_next ? (const char*)g.A + (size_t)nxt.pm * tstep : cA; const char* nB = has_next ? (const char*)g.Bt + (size_t)nxt.pn * tstep + (size_t)(nxt.pm >> 5) * g.bstride : cB;
        for (int t = 0; t < nt; t += 2) {
            const bool last = (t == nt - 2);
            const char* a1 = cA + (size_t)(t + 1) * kstep;
            const char* a2 = last ? nA : cA + (size_t)(t + 2) * kstep; const char* b2 = last ? nB : cB + (size_t)(t + 2) * kstep;
            const char* a3 = a2 + kstep; const char* b3 = b2 + kstep;
            if (last && has_next) S.a_ready(nxt);
            if constexpr (SP2) {
            PG8_LDB(B0, 0, 0); PG8_LDB(B1, 0, 1); PG8_SCHED; PG8_LDA(At, 0, 0); PG8_STAGE(PG8_SA(1, 1), a1 + hstep, voffA);
            PG8_WAIT_V(8); PG8_WAIT_L(0); PG8_BAR; PG8_MMA(0, 0, At, B0); PG8_MMA(0, 1, At, B1); PG8_BAR; PG8_SCHED;
            PG8_LDA(At, 0, 1); PG8_STAGE(PG8_SB(0, 0), b2, voffB); PG8_STAGE(PG8_SB(0, 1), b2 + hstep, voffB); PG8_STAGE(PG8_SA(0, 0), a2, voffA);
            PG8_WAIT_V(8); PG8_WAIT_L(0); PG8_BAR; PG8_MMA(1, 0, At, B0); PG8_MMA(1, 1, At, B1); PG8_BAR; PG8_SCHED;
            PG8_LDB(B0, 1, 0); PG8_LDB(B1, 1, 1); PG8_SCHED; PG8_LDA(At, 1, 0); PG8_STAGE(PG8_SA(0, 1), a2 + hstep, voffA);
            PG8_WAIT_V(8); PG8_WAIT_L(0); PG8_BAR; PG8_MMA(0, 0, At, B0); PG8_MMA(0, 1, At, B1); PG8_BAR; PG8_SCHED;
            PG8_LDA(At, 1, 1); PG8_STAGE(PG8_SB(1, 0), b3, voffB); PG8_STAGE(PG8_SB(1, 1), b3 + hstep, voffB); PG8_STAGE(PG8_SA(1, 0), a3, voffA);
            PG8_WAIT_V(8); PG8_WAIT_L(0); PG8_BAR; PG8_MMA(1, 0, At, B0); PG8_MMA(1, 1, At, B1); PG8_BAR; PG8_SCHED;
            } else {
            PG8_LDB(B0, 0, 0); PG8_SCHED; PG8_LDA(At, 0, 0); PG8_STAGE(PG8_SA(1, 1), a1 + hstep, voffA);
            PG8_WAIT_L(8); PG8_BAR; PG8_WAIT_L(0); PG8_MMA(0, 0, At, B0); PG8_BAR; PG8_SCHED;
            PG8_LDB(B1, 0, 1); PG8_STAGE(PG8_SB(0, 0), b2, voffB);
            PG8_BAR; PG8_WAIT_L(0); PG8_MMA(0, 1, At, B1); PG8_BAR;
            PG8_LDA(At, 0, 1); PG8_STAGE(PG8_SA(0, 0), a2, voffA);
            PG8_BAR; PG8_WAIT_L(0); PG8_MMA(1, 0, At, B0); PG8_BAR; PG8_SCHED;
            PG8_STAGE(PG8_SB(0, 1), b2 + hstep, voffB);
            PG8_WAIT_V(6); PG8_BAR; PG8_MMA(1, 1, At, B1); PG8_BAR;
            PG8_LDB(B0, 1, 0); PG8_SCHED; PG8_LDA(At, 1, 0); PG8_STAGE(PG8_SA(0, 1), a2 + hstep, voffA);
            PG8_WAIT_L(8); PG8_BAR; PG8_WAIT_L(0); PG8_MMA(0, 0, At, B0); PG8_BAR; PG8_SCHED;
            PG8_LDB(B1, 1, 1); PG8_STAGE(PG8_SB(1, 0), b3, voffB);
            PG8_BAR; PG8_WAIT_L(0); PG8_MMA(0, 1, At, B1); PG8_BAR;
            PG8_LDA(At, 1, 1); PG8_STAGE(PG8_SA(1, 0), a3, voffA);
            PG8_BAR; PG8_WAIT_L(0); PG8_MMA(1, 0, At, B0); PG8_BAR; PG8_SCHED;
            PG8_STAGE(PG8_SB(1, 1), b3 + hstep, voffB);
            PG8_WAIT_V(6); PG8_BAR; PG8_MMA(1, 1, At, B1); PG8_BAR;
            }
        }
        if constexpr (ALIGN_EPI) { if (wr == 0) PG8_BAR; }
        if constexpr (!Epi::AFTER_DRAIN) { E(acc, cur, wr, wc, fr, fq); S.done(cur); }
        if (!has_next) break;
#pragma unroll
        for (int a = 0; a < 2; ++a)
#pragma unroll
            for (int b = 0; b < 2; ++b)
#pragma unroll
                for (int m = 0; m < 4; ++m)
#pragma unroll
                    for (int n = 0; n < 2; ++n) acc[a][b][m][n] = (f32x4){0.f, 0.f, 0.f, 0.f};
        cur = nxt; cA = nA; cB = nB; ++ui;
        if constexpr (ALIGN_EPI) { if (wr == 1) PG8_BAR; }
    }
    PG8_WAIT_V(0);
    if constexpr (!ALIGN_EPI) { if (wr == 0) PG8_BAR; }
    PG8_BAR;
    if constexpr (Epi::AFTER_DRAIN) { E.fused(acc, cur, wr, wc, fr, fq, lds, wid, lane); S.done(cur); }
#undef PG8_SA
#undef PG8_SB
#undef PG8_STAGE
#undef PG8_LDA
#undef PG8_LDB
#undef PG8_MMA
#undef PG8_WAIT_V
#undef PG8_WAIT_L
#undef PG8_BAR
#undef PG8_SCHED
}
}

#ifndef MK_MULTI
#define MK_MULTI 0
#endif
#define LAS __attribute__((address_space(3)))
typedef unsigned short bf16;
typedef unsigned v4u __attribute__((ext_vector_type(4)));
typedef unsigned v2u __attribute__((ext_vector_type(2)));
typedef float f32x4 __attribute__((ext_vector_type(4)));
typedef short bf16x8 __attribute__((ext_vector_type(8)));

constexpr int NB = 2, SEQ = 8192, MTOK = NB * SEQ, DM = 1024, FF = 2816, DIN = 3212, DINP = 3328, NGU = 2 * FF;
constexpr int MQ0 = 512, MK0 = 896, MV0 = 1280, GQ0 = 1664, GZ0 = 2816, GA0 = 3200, GB0 = 3206;
constexpr int NPH = 22;
constexpr float EPS = 1e-6f;
constexpr size_t MiB = 1u << 20;
constexpr size_t WS_RS = 0, WS_MOD = 458752, WS_BIAS = 606208, CTL_ZERO = 1 * MiB;
constexpr int BIAS_L = 2 * (NGU + DINP + NGU);
constexpr size_t WS_ROPE = 1 * MiB, WS_KMEAN = 1 * MiB + 512 * 1024, WS_KNMAX = WS_KMEAN + 98304, WS_EGL = WS_KMEAN + 102400;
constexpr size_t WS_W = 2 * MiB;
constexpr size_t W_1GU = 0, W_D1 = 22 * MiB, W_IN = W_D1 + 5 * MiB + 512 * 1024, W_OUT = W_IN + 13 * MiB, W_2GU = W_OUT + 2 * MiB, W_D2 = W_2GU + 22 * MiB;
constexpr size_t WS_XB = 72 * MiB, WS_AQD = 72 * MiB, WS_AKD = 84 * MiB;
constexpr size_t WS_U = 104 * MiB, WS_Y = 208 * MiB, WS_AW = 240 * MiB, WS_AQK = 252 * MiB, WS_UD = 264 * MiB, WS_VT = 276 * MiB, WS_SV = 288 * MiB, WS_END = 300 * MiB;
constexpr size_t WS_KT = WS_W + W_IN;
static_assert(W_D2 + 5 * MiB + 512 * 1024 == 70 * MiB, "weights");
constexpr int LDS_BYTES = 163840;
constexpr size_t WS_BAR = 851968;
constexpr int LDS_BARST = 163776;

struct Params { const float* in[24]; float* out; unsigned char* ws; int ph_lo, ph_hi; };

__device__ __forceinline__ float bf2f(bf16 v) { return __uint_as_float(((unsigned)v) << 16); }
typedef float f32x2_t __attribute__((ext_vector_type(2)));
typedef __bf16 bf16x2_t __attribute__((ext_vector_type(2)));
__device__ __forceinline__ unsigned pk2(float lo, float hi) { const f32x2_t v = {lo, hi}; const bf16x2_t b = __builtin_convertvector(v, bf16x2_t); return __builtin_bit_cast(unsigned, b); }
__device__ __forceinline__ float sigmoid_f(float x) { return __builtin_amdgcn_rcpf(1.f + __expf(-x)); }
__device__ __forceinline__ float silu_f(float x) { return x * sigmoid_f(x); }
__device__ __forceinline__ float wave_sum(float v) {
#pragma unroll
    for (int o = 1; o < 64; o <<= 1) v += __shfl_xor(v, o);
    return v;
}
__device__ __forceinline__ void gadd(float* p, float v) { __hip_atomic_fetch_add(p, v, __ATOMIC_RELAXED, __HIP_MEMORY_SCOPE_AGENT); }
__device__ __forceinline__ void ladd(LAS float* p, float v) { __hip_atomic_fetch_add(p, v, __ATOMIC_RELAXED, __HIP_MEMORY_SCOPE_WORKGROUP); }
__device__ __forceinline__ bf16x8 pack8(f32x4 a, f32x4 b) {
    v4u w; w.x = pk2(a[0], a[1]); w.y = pk2(a[2], a[3]); w.z = pk2(b[0], b[1]); w.w = pk2(b[2], b[3]);
    return __builtin_bit_cast(bf16x8, w);
}
#define MFMA16(a, b, c) __builtin_amdgcn_mfma_f32_16x16x32_bf16((a), (b), (c), 0, 0, 0)

#define XB_TMO      128
#define XB_XCNT(j)  (256  + 64 * (j))
#define XB_XSUB(j)  (1280 + 64 * (j))
#define XB_XGEN(j)  (2304 + 64 * (j))
#define XB_TOP      3328
#define XB_TOPGEN   3392
#define XCD_BAR_WORDS 3456
#define XB_SPIN_CAP (1u << 18)

__device__ __forceinline__ unsigned xb_ld(unsigned* p)              { return __hip_atomic_load(p, __ATOMIC_RELAXED, __HIP_MEMORY_SCOPE_AGENT); }
__device__ __forceinline__ unsigned xb_add(unsigned* p, unsigned v) { return __hip_atomic_fetch_add(p, v, __ATOMIC_RELAXED, __HIP_MEMORY_SCOPE_AGENT); }
__device__ __forceinline__ unsigned xb_xcc_id() { return (unsigned)__builtin_amdgcn_s_getreg((3 << 11) | 20) & 0xFu; }
#define XB_SPIN(cond, bar) do { unsigned _sp = 0; while (cond) { __builtin_amdgcn_s_sleep(1); \
    if ((++_sp & 255u) == 0u) { if (xb_ld(&(bar)[XB_TMO])) break; if (_sp > XB_SPIN_CAP) { atomicAdd(&(bar)[XB_TMO], 1u); break; } } } } while (0)

struct XcdBarrier {
    unsigned* bar; unsigned x;
    volatile LAS unsigned* st;
};

__device__ __forceinline__ XcdBarrier xcd_barrier_post(unsigned* bar, volatile LAS unsigned* st) {
    XcdBarrier b; b.bar = bar; b.x = xb_xcc_id(); b.st = st;
    if (threadIdx.x == 0) (void)xb_add(&bar[XB_XCNT(b.x)], 1u);
    return b;
}
__device__ __forceinline__ void xcd_barrier_complete(unsigned* bar, unsigned x, unsigned& nloc, unsigned& nx) {
    const unsigned G = gridDim.x * gridDim.y * gridDim.z;
    unsigned sum, cnt, mine, sp = 0u;
    for (;;) {
        sum = 0u; cnt = 0u; mine = 0u;
#pragma unroll
        for (unsigned j = 0; j < 16; ++j) { const unsigned c = xb_ld(&bar[XB_XCNT(j)]); sum += c; cnt += (c > 0u) ? 1u : 0u; mine = (j == x) ? c : mine; }
        if (sum == G) break;
        __builtin_amdgcn_s_sleep(1);
        if ((++sp & 255u) == 0u) { if (xb_ld(&bar[XB_TMO])) break; if (sp > XB_SPIN_CAP) { atomicAdd(&bar[XB_TMO], 1u); break; } }
    }
    nloc = mine > 0u ? mine : 1u; nx = cnt > 0u ? cnt : 1u;
}

__device__ __forceinline__ void xcd_barrier(const XcdBarrier& b) {
    asm volatile("s_waitcnt vmcnt(0)" ::: "memory");
    __syncthreads();
    if (threadIdx.x == 0) {
        unsigned* bar = b.bar;
        __builtin_amdgcn_s_waitcnt(0);
        unsigned nloc = b.st[0], nx = b.st[1];
        if (nloc == 0u) { xcd_barrier_complete(bar, b.x, nloc, nx); b.st[0] = nloc; b.st[1] = nx; }
        const unsigned old = xb_add(&bar[XB_XSUB(b.x)], 1u);
        const unsigned gen = old / nloc;
        if (old + 1u == (gen + 1u) * nloc) {
            __builtin_amdgcn_fence(__ATOMIC_RELEASE, "agent");
            asm volatile("s_waitcnt vmcnt(0)" ::: "memory");
            const unsigned og = xb_add(&bar[XB_TOP], 1u);
            const unsigned tg = og / nx;
            if (og + 1u == (tg + 1u) * nx) xb_add(&bar[XB_TOPGEN], 1u);
            else XB_SPIN(xb_ld(&bar[XB_TOPGEN]) == tg, bar);
            __builtin_amdgcn_fence(__ATOMIC_ACQUIRE, "agent");
            xb_add(&bar[XB_XGEN(b.x)], 1u);
            asm volatile("s_waitcnt vmcnt(0)" ::: "memory");
        } else {
            XB_SPIN(xb_ld(&bar[XB_XGEN(b.x)]) == gen, bar);
            __builtin_amdgcn_fence(__ATOMIC_ACQUIRE, "agent");
            asm volatile("s_waitcnt vmcnt(0)" ::: "memory");
        }
    }
    __syncthreads();
}

struct EpiGU {
    static constexpr bool PERM = true, AFTER_DRAIN = false;
    bf16* act; const float* rs; const float* bias;
    __device__ __forceinline__ void operator()(const f32x4 (&acc)[2][2][4][2], const pg8::Unit& u, int wr, int wc, int fr, int fq) const {
        const int b = u.pm >> 5;
        const float* bb = bias + b * NGU + u.pn * 256 + wc * 32 + 8 * fq;
        const f32x4 bg0 = *(const f32x4*)(bb), bg1 = *(const f32x4*)(bb + 4), bu0 = *(const f32x4*)(bb + 128), bu1 = *(const f32x4*)(bb + 132);
        float rsall[2][4];
#pragma unroll
        for (int ai = 0; ai < 2; ++ai)
#pragma unroll
            for (int m = 0; m < 4; ++m) rsall[ai][m] = rs[u.pm * 256 + ai * 128 + wr * 64 + m * 16 + fr];
#pragma unroll
        for (int ai = 0; ai < 2; ++ai)
#pragma unroll
            for (int m = 0; m < 4; ++m) {
                const int row = u.pm * 256 + ai * 128 + wr * 64 + m * 16 + fr;
                const float rstd = rsqrtf(rsall[ai][m] * (1.f / DM) + EPS);
                const f32x4 g0 = acc[ai][0][m][0] * rstd + bg0, g1 = acc[ai][0][m][1] * rstd + bg1;
                const f32x4 u0 = acc[ai][1][m][0] * rstd + bu0, u1 = acc[ai][1][m][1] * rstd + bu1;
                v4u w;
                w.x = pk2(silu_f(g0[0]) * u0[0], silu_f(g0[1]) * u0[1]); w.y = pk2(silu_f(g0[2]) * u0[2], silu_f(g0[3]) * u0[3]);
                w.z = pk2(silu_f(g1[0]) * u1[0], silu_f(g1[1]) * u1[1]); w.w = pk2(silu_f(g1[2]) * u1[2], silu_f(g1[3]) * u1[3]);
                *(v4u*)(act + (size_t)row * FF + u.pn * 128 + wc * 32 + 8 * fq) = w;
            }
    }
};
struct EpiRes {
    static constexpr bool PERM = true, AFTER_DRAIN = false;
    const float* xin; float* x; bf16* xb; float* rsn; const float* gate; float gmul;
    __device__ __forceinline__ void operator()(const f32x4 (&acc)[2][2][4][2], const pg8::Unit& u, int wr, int wc, int fr, int fq) const {
        const int b = u.pm >> 5, col0 = u.pn * 256 + wc * 32 + 8 * fq;
        f32x4 (&ac)[2][2][4][2] = const_cast<f32x4 (&)[2][2][4][2]>(acc);
        {   f32x4 gt[2][2];
#pragma unroll
            for (int bj = 0; bj < 2; ++bj)
#pragma unroll
                for (int n = 0; n < 2; ++n) gt[bj][n] = *(const f32x4*)(gate + b * 9216 + col0 + 128 * bj + 4 * n) * gmul;
#pragma unroll
            for (int ai = 0; ai < 2; ++ai)
#pragma unroll
                for (int bj = 0; bj < 2; ++bj)
#pragma unroll
                    for (int m = 0; m < 4; ++m) { ac[ai][bj][m][0] *= gt[bj][0]; ac[ai][bj][m][1] *= gt[bj][1]; } }
#pragma unroll
        for (int bt = 0; bt < 3; ++bt) {
            const int g0 = 3 * bt, ng = bt < 2 ? 3 : 2;
            f32x4 xv[3][2][2];
#pragma unroll
            for (int gi = 0; gi < 3; ++gi) if (gi < ng) { const int ai = (g0 + gi) >> 2, m = (g0 + gi) & 3;
#pragma unroll
                for (int bj = 0; bj < 2; ++bj) { const float* pi = xin + (size_t)(u.pm * 256 + ai * 128 + wr * 64 + m * 16 + fr) * DM + col0 + 128 * bj; xv[gi][bj][0] = *(const f32x4*)pi; xv[gi][bj][1] = *(const f32x4*)(pi + 4); } }
#pragma unroll
            for (int gi = 0; gi < 3; ++gi) if (gi < ng) {
                const int ai = (g0 + gi) >> 2, m = (g0 + gi) & 3, row = u.pm * 256 + ai * 128 + wr * 64 + m * 16 + fr;
                float ss = 0.f;
#pragma unroll
                for (int bj = 0; bj < 2; ++bj) {
                    float* px = x + (size_t)row * DM + col0 + 128 * bj;
                    f32x4 x0 = xv[gi][bj][0] + ac[ai][bj][m][0], x1 = xv[gi][bj][1] + ac[ai][bj][m][1];
                    *(f32x4*)px = x0; *(f32x4*)(px + 4) = x1;
                    ss += (x0[0] * x0[0] + x0[1] * x0[1]) + (x0[2] * x0[2] + x0[3] * x0[3]) + (x1[0] * x1[0] + x1[1] * x1[1]) + (x1[2] * x1[2] + x1[3] * x1[3]);
                    v4u w; w.x = pk2(x0[0], x0[1]); w.y = pk2(x0[2], x0[3]); w.z = pk2(x1[0], x1[1]); w.w = pk2(x1[2], x1[3]);
                    *(v4u*)(xb + (size_t)row * DM + col0 + 128 * bj) = w;
                }
                ss += __shfl_xor(ss, 16); ss += __shfl_xor(ss, 32);
                if (fq == 0) gadd(rsn + row, ss);
            }
            asm volatile("" ::: "memory");
        }
    }
};
struct EpiIn {
    static constexpr bool PERM = true, AFTER_DRAIN = false;
    bf16* U; const float* rs; const float* bias; const float* rope;
    __device__ __forceinline__ void operator()(const f32x4 (&acc)[2][2][4][2], const pg8::Unit& u, int wr, int wc, int fr, int fq) const {
        const int b = u.pm >> 5, col0 = u.pn * 256 + wc * 32 + 8 * fq;
        const bool ropetile = (u.pn >= 2 && u.pn <= 4);
        const bool ropelane = ropetile && !(wc & 1) && fq < 2;
        const float* bp = bias + b * DINP + col0;
        f32x4 bv[2][2];
#pragma unroll
        for (int bj = 0; bj < 2; ++bj) { bv[bj][0] = *(const f32x4*)(bp + 128 * bj); bv[bj][1] = *(const f32x4*)(bp + 128 * bj + 4); }
        const float sg = fq == 0 ? -1.f : 1.f;
        float rsall[2][4];
#pragma unroll
        for (int ai = 0; ai < 2; ++ai)
#pragma unroll
            for (int m = 0; m < 4; ++m) rsall[ai][m] = rs[u.pm * 256 + ai * 128 + wr * 64 + m * 16 + fr];
#pragma unroll
        for (int am = 0; am < 4; ++am) {
            const int ai = am >> 1, m0 = (am & 1) * 2;
            f32x4 cs[2][4];
            if (ropelane) {
#pragma unroll
                for (int mm = 0; mm < 2; ++mm) { const float* rp = rope + (size_t)((u.pm * 256 + ai * 128 + wr * 64 + (m0 + mm) * 16 + fr) & (SEQ - 1)) * 16;
                    cs[mm][0] = *(const f32x4*)rp; cs[mm][1] = *(const f32x4*)(rp + 4); cs[mm][2] = *(const f32x4*)(rp + 8) * sg; cs[mm][3] = *(const f32x4*)(rp + 12) * sg; } }
#pragma unroll
            for (int mm = 0; mm < 2; ++mm) {
                const int m = m0 + mm, row = u.pm * 256 + ai * 128 + wr * 64 + m * 16 + fr;
                const float rst = rsqrtf(rsall[ai][m] * (1.f / DM) + EPS);
#pragma unroll
                for (int bj = 0; bj < 2; ++bj) {
                    f32x4 v0 = acc[ai][bj][m][0] * rst + bv[bj][0], v1 = acc[ai][bj][m][1] * rst + bv[bj][1];
                    if (ropetile) {
                        f32x4 p0, p1;
#pragma unroll
                        for (int j = 0; j < 4; ++j) { p0[j] = __shfl_xor(v0[j], 16); p1[j] = __shfl_xor(v1[j], 16); }
                        if (ropelane) { v0 = v0 * cs[mm][0] + p0 * cs[mm][2]; v1 = v1 * cs[mm][1] + p1 * cs[mm][3]; }
                    }
                    v4u w; w.x = pk2(v0[0], v0[1]); w.y = pk2(v0[2], v0[3]); w.z = pk2(v1[0], v1[1]); w.w = pk2(v1[2], v1[3]);
                    *(v4u*)(U + (size_t)row * DINP + col0 + 128 * bj) = w;
                }
            }
            asm volatile("" ::: "memory");
        }
    }
};

__device__ __forceinline__ void phase_pre(const Params& p, int tid, int wave, int lane) {
    const int gw = blockIdx.x * 8 + wave, NGW = gridDim.x * 8;
    const float* x = p.in[0]; bf16* xb = (bf16*)(p.ws + WS_XB); float* rs = (float*)(p.ws + WS_RS);
    for (int row0 = gw; row0 < MTOK; row0 += 4 * NGW) {
        f32x4 v[4][4];
#pragma unroll
        for (int rr = 0; rr < 4; ++rr) { const int row = row0 + rr * NGW; const f32x4* xr = (const f32x4*)(x + (size_t)(row < MTOK ? row : row0) * DM) + lane;
#pragma unroll
            for (int j = 0; j < 4; ++j) v[rr][j] = xr[64 * j]; }
#pragma unroll
        for (int rr = 0; rr < 4; ++rr) { const int row = row0 + rr * NGW; if (row < MTOK) {
            v2u* xbr = (v2u*)(xb + (size_t)row * DM) + lane; float ss = 0.f;
#pragma unroll
            for (int j = 0; j < 4; ++j) { const f32x4 t = v[rr][j]; ss += (t[0] * t[0] + t[1] * t[1]) + (t[2] * t[2] + t[3] * t[3]);
                v2u w; w.x = pk2(t[0], t[1]); w.y = pk2(t[2], t[3]); xbr[64 * j] = w; }
            ss = wave_sum(ss); if (lane == 0) rs[row] = ss; } }
    }
    const float* cvec = p.in[1]; const float* w_ada = p.in[2]; const float* b_ada = p.in[3]; float* mod = (float*)(p.ws + WS_MOD);
    for (int it = gw; it < 2304; it += NGW) {
        const int l = it / 1152, r = it % 1152, nc = r >> 5, kr = r & 31;
        const float* W = w_ada + ((size_t)l * 1024 + kr * 32) * 9216 + nc * 256 + lane * 4;
        f32x4 a0 = {0.f, 0.f, 0.f, 0.f}, a1 = a0;
#pragma unroll
        for (int k = 0; k < 32; ++k) { const f32x4 w = *(const f32x4*)(W + (size_t)k * 9216); const float c0 = silu_f(cvec[kr * 32 + k]), c1 = silu_f(cvec[1024 + kr * 32 + k]); a0 += w * c0; a1 += w * c1; }
        if (kr == 0) { const f32x4 bb = *(const f32x4*)(b_ada + l * 9216 + nc * 256 + lane * 4); a0 += bb; a1 += bb; }
        float* m0 = mod + (l * 2 + 0) * 9216 + nc * 256 + lane * 4; float* m1 = m0 + 9216;
#pragma unroll
        for (int j = 0; j < 4; ++j) { gadd(m0 + j, a0[j]); gadd(m1 + j, a1[j]); }
    }
    float* rope = (float*)(p.ws + WS_ROPE);
    for (int idx = blockIdx.x * 512 + tid; idx < SEQ * 8; idx += gridDim.x * 512) {
        const int pos = idx >> 3, i = idx & 7; const float inv = expf(-logf(500000.0f) * (float)(2 * i) / 16.0f); const float ang = (float)pos * inv;
        float s, c; sincosf(ang, &s, &c); rope[pos * 16 + i] = c; rope[pos * 16 + 8 + i] = s;
    }
}

__device__ __forceinline__ int rowmap(int n, int mode) { return mode == 0 ? n : (((n >> 7) << 8) + (n & 127) + (mode == 2 ? 128 : 0)); }
__device__ __forceinline__ void cvt_tile(const float* W, int K, int N, bf16* WT0, bf16* WT1, int mode, const float* g, const float* sc0, const float* sc1, const float* sh0, const float* sh1,
                                         float* bias0, float* bias1, int kb, int nb, LAS float* scr, int lane) {
    const int k0 = 64 * kb, n0 = 64 * nb, n = n0 + lane; const bool valid = n < N;
    {   const int r4 = lane >> 4, c4 = lane & 15; const bool v4ok = (n0 + 4 * c4) < N;
        f32x4 wv[16];
#pragma unroll
        for (int i = 0; i < 16; ++i) wv[i] = v4ok ? *(const f32x4*)(W + (size_t)(k0 + 4 * i + r4) * N + n0 + 4 * c4) : (f32x4){0.f, 0.f, 0.f, 0.f};
#pragma unroll
        for (int i = 0; i < 16; ++i) { LAS float* d = scr + (4 * i + r4) * 65 + 4 * c4; d[0] = wv[i][0]; d[1] = wv[i][1]; d[2] = wv[i][2]; d[3] = wv[i][3]; } }
    if (g) {
        float s0 = 0.f, s1 = 0.f;
        const unsigned sh0v = __float_as_uint(sh0[k0 + lane]), sh1v = __float_as_uint(sh1[k0 + lane]);
#pragma unroll
        for (int i = 0; i < 64; ++i) { const float w = scr[i * 65 + lane];
            s0 += w * __uint_as_float((unsigned)__builtin_amdgcn_readlane((int)sh0v, i)); s1 += w * __uint_as_float((unsigned)__builtin_amdgcn_readlane((int)sh1v, i)); }
        if (valid) { gadd(bias0 + rowmap(n, mode), s0); gadd(bias1 + rowmap(n, mode), s1); }
    }
    const int c = lane & 7;
    float k0s[8], k1s[8];
#pragma unroll
    for (int t = 0; t < 8; ++t) { if (g) { const float gk = g[k0 + 8 * c + t]; k0s[t] = gk * (1.f + sc0[k0 + 8 * c + t]); k1s[t] = gk * (1.f + sc1[k0 + 8 * c + t]); } else { k0s[t] = 1.f; k1s[t] = 1.f; } }
#pragma unroll
    for (int j = 0; j < 8; ++j) {
        const int nn = (lane >> 3) + 8 * j; const size_t row = (size_t)rowmap(n0 + nn, mode);
        float v[8];
#pragma unroll
        for (int t = 0; t < 8; ++t) v[t] = scr[(8 * c + t) * 65 + nn];
        v4u o; o.x = pk2(v[0] * k0s[0], v[1] * k0s[1]); o.y = pk2(v[2] * k0s[2], v[3] * k0s[3]); o.z = pk2(v[4] * k0s[4], v[5] * k0s[5]); o.w = pk2(v[6] * k0s[6], v[7] * k0s[7]);
        *(v4u*)(WT0 + row * K + k0 + 8 * c) = o;
        if (WT1) { v4u q; q.x = pk2(v[0] * k1s[0], v[1] * k1s[1]); q.y = pk2(v[2] * k1s[2], v[3] * k1s[3]); q.z = pk2(v[4] * k1s[4], v[5] * k1s[5]); q.w = pk2(v[6] * k1s[6], v[7] * k1s[7]);
            *(v4u*)(WT1 + row * K + k0 + 8 * c) = q; }
    }
}
__device__ __forceinline__ void phase_cvt(const Params& p, int l, LAS unsigned char* lds, int wave, int lane, int lo, int hi, int gw, int NGW) {
    LAS float* scr = (LAS float*)(lds + wave * 16640);
    unsigned char* wb = p.ws + WS_W; const float* mod0 = (const float*)(p.ws + WS_MOD) + (l * 2) * 9216; const float* mod1 = mod0 + 9216;
    float* bias = (float*)(p.ws + WS_BIAS) + l * BIAS_L;
    for (int it = lo + gw; it < hi; it += NGW) {
        int r = it;
        if (r < 1408) { const int up = r >= 704; r -= up * 704; const float* W = p.in[up ? 6 : 5] + (size_t)l * DM * FF;
            cvt_tile(W, DM, FF, (bf16*)(wb + W_1GU), (bf16*)(wb + W_1GU) + (size_t)NGU * DM, 1 + up, p.in[4] + l * DM, mod0 + 1024, mod1 + 1024, mod0, mod1, bias, bias + NGU, r / 44, r % 44, scr, lane); continue; }
        r -= 1408;
        if (r < 704) { cvt_tile(p.in[7] + (size_t)l * FF * DM, FF, DM, (bf16*)(wb + W_D1), nullptr, 0, nullptr, nullptr, nullptr, nullptr, nullptr, nullptr, nullptr, r / 16, r % 16, scr, lane); continue; }
        r -= 704;
        if (r < 832) { cvt_tile(p.in[9] + (size_t)l * DM * DIN, DM, DIN, (bf16*)(wb + W_IN), (bf16*)(wb + W_IN) + (size_t)DINP * DM, 0, p.in[8] + l * DM, mod0 + 4096, mod1 + 4096, mod0 + 3072, mod1 + 3072,
                                bias + 2 * NGU, bias + 2 * NGU + DINP, r / 52, r % 52, scr, lane); continue; }
        r -= 832;
        if (r < 256) { cvt_tile(p.in[18] + (size_t)l * DM * DM, DM, DM, (bf16*)(wb + W_OUT), nullptr, 0, nullptr, nullptr, nullptr, nullptr, nullptr, nullptr, nullptr, r / 16, r % 16, scr, lane); continue; }
        r -= 256;
        if (r < 1408) { const int up = r >= 704; r -= up * 704; const float* W = p.in[up ? 21 : 20] + (size_t)l * DM * FF;
            cvt_tile(W, DM, FF, (bf16*)(wb + W_2GU), (bf16*)(wb + W_2GU) + (size_t)NGU * DM, 1 + up, p.in[19] + l * DM, mod0 + 7168, mod1 + 7168, mod0 + 6144, mod1 + 6144,
                     bias + 2 * NGU + 2 * DINP, bias + 2 * NGU + 2 * DINP + NGU, r / 44, r % 44, scr, lane); continue; }
        r -= 1408;
        cvt_tile(p.in[22] + (size_t)l * FF * DM, FF, DM, (bf16*)(wb + W_D2), nullptr, 0, nullptr, nullptr, nullptr, nullptr, nullptr, nullptr, nullptr, r / 16, r % 16, scr, lane);
    }
}

__device__ __forceinline__ void conv_item(const Params& p, int l, int item, LAS float* hs, int tid, int wave, int lane) {
    const bf16* U = (const bf16*)(p.ws + WS_U); bf16* Y = (bf16*)(p.ws + WS_Y);
    const int t0 = item * 64, b = t0 >> 13, tp0 = t0 & (SEQ - 1);
    const int c = tid & 255, hf = tid >> 8;
    float w[31], acc[32];
#pragma unroll
    for (int k = 0; k < 31; ++k) w[k] = p.in[10][(l * 31 + k) * 256 + c];
    const float bias = p.in[11][l * 256 + c];
    {   v4u av[6], gv[6];
#pragma unroll
        for (int i = 0; i < 6; ++i) { const int ti = tid + 512 * i, r = ti >> 5, c8 = ti & 31, tp = tp0 - 30 + r; av[i] = (v4u){0u, 0u, 0u, 0u}; gv[i] = av[i];
            if (ti < 3008 && tp >= 0) { const bf16* ur = U + (size_t)(b * SEQ + tp) * DINP + 8 * c8; av[i] = *(const v4u*)ur; gv[i] = *(const v4u*)(ur + 256); } }
#pragma unroll
        for (int i = 0; i < 6; ++i) { const int ti = tid + 512 * i, r = ti >> 5, c8 = ti & 31;
            if (ti < 3008) { const unsigned aw[4] = {av[i].x, av[i].y, av[i].z, av[i].w}, gw[4] = {gv[i].x, gv[i].y, gv[i].z, gv[i].w};
                float hv8[8];
#pragma unroll
                for (int j = 0; j < 4; ++j) { hv8[2 * j] = __uint_as_float(aw[j] << 16) * sigmoid_f(__uint_as_float(gw[j] << 16));
                    hv8[2 * j + 1] = __uint_as_float(aw[j] & 0xffff0000u) * sigmoid_f(__uint_as_float(gw[j] & 0xffff0000u)); }
                *(LAS f32x4*)(hs + r * 256 + 8 * c8) = (f32x4){hv8[0], hv8[1], hv8[2], hv8[3]}; *(LAS f32x4*)(hs + r * 256 + 8 * c8 + 4) = (f32x4){hv8[4], hv8[5], hv8[6], hv8[7]}; } }
    }
    __syncthreads();
#pragma unroll
    for (int r = 0; r < 32; ++r) acc[r] = bias;
#pragma unroll
    for (int j = 0; j < 62; ++j) { const float hv = hs[(32 * hf + j) * 256 + c];
#pragma unroll
        for (int r = 0; r < 32; ++r) { const int k = j - r; if (k >= 0 && k < 31) acc[r] += hv * w[k]; } }
    __syncthreads();
#pragma unroll
    for (int r = 0; r < 32; ++r) hs[(32 * hf + r) * 256 + c] = acc[r];
    __syncthreads();
    const float* lg = p.in[12] + l * 256; const float* lb = p.in[13] + l * 256;
    const f32x4 lgv = *(const f32x4*)(lg + 4 * lane), lbv = *(const f32x4*)(lb + 4 * lane);
    for (int rr = 0; rr < 8; ++rr) { const int row = wave * 8 + rr;
        f32x4 v = *(const LAS f32x4*)(hs + row * 256 + 4 * lane);
        const float mu = wave_sum((v[0] + v[1]) + (v[2] + v[3])) * (1.f / 256.f);
        v -= mu;
        const float rstd = rsqrtf(wave_sum((v[0] * v[0] + v[1] * v[1]) + (v[2] * v[2] + v[3] * v[3])) * (1.f / 256.f) + EPS);
        const f32x4 yv = v * rstd * lgv + lbv;
        v2u w; w.x = pk2(silu_f(yv[0]), silu_f(yv[1])); w.y = pk2(silu_f(yv[2]), silu_f(yv[3]));
        *(v2u*)(Y + (size_t)(t0 + row) * DM + 4 * lane) = w; }
    __syncthreads();
}
__device__ __forceinline__ void mobaprep_item(const Params& p, int item, LAS unsigned char* lds, int tid) {
    const bf16* U = (const bf16*)(p.ws + WS_U);
    const int bh = item >> 5, j = item & 31, b = bh / 6, h = bh % 6; const size_t base = (size_t)b * SEQ + j * 256;
    LAS unsigned* vs = (LAS unsigned*)lds;
    LAS unsigned* ksl = (LAS unsigned*)(lds + 33792);
    LAS float* ksum = (LAS float*)(lds + 67584);
    LAS unsigned* kmx = (LAS unsigned*)(lds + 67584 + 2048);
    v4u kv[4], vv[4];
#pragma unroll
    for (int i = 0; i < 4; ++i) { const int idx = tid + 512 * i, row = idx >> 3, pc = idx & 7; const bf16* rp = U + (base + row) * DINP + h * 64 + 8 * pc; kv[i] = *(const v4u*)(rp + MK0); vv[i] = *(const v4u*)(rp + MV0); }
    if (tid == 0) kmx[0] = 0u;
    __syncthreads();
    float nmax = 0.f;
#pragma unroll
    for (int i = 0; i < 4; ++i) { const int idx = tid + 512 * i, row = idx >> 3, pc = idx & 7;
        LAS unsigned* dk = ksl + row * 33 + 4 * pc; dk[0] = kv[i].x; dk[1] = kv[i].y; dk[2] = kv[i].z; dk[3] = kv[i].w;
        LAS unsigned* dv = vs + row * 33 + 4 * pc; dv[0] = vv[i].x; dv[1] = vv[i].y; dv[2] = vv[i].z; dv[3] = vv[i].w;
        const unsigned w4[4] = {kv[i].x, kv[i].y, kv[i].z, kv[i].w}; float ss = 0.f;
#pragma unroll
        for (int t = 0; t < 4; ++t) { const float a0 = __uint_as_float(w4[t] << 16), a1 = __uint_as_float(w4[t] & 0xffff0000u); ss += a0 * a0 + a1 * a1; }
        ss += __shfl_xor(ss, 1); ss += __shfl_xor(ss, 2); ss += __shfl_xor(ss, 4);
        nmax = fmaxf(nmax, ss); }
#pragma unroll
    for (int o = 8; o < 64; o <<= 1) nmax = fmaxf(nmax, __shfl_xor(nmax, o));
    if ((tid & 63) == 0) __hip_atomic_fetch_max(kmx, __float_as_uint(sqrtf(nmax)), __ATOMIC_RELAXED, __HIP_MEMORY_SCOPE_WORKGROUP);
    __syncthreads();
    { const int d = tid & 63, part = tid >> 6; const LAS bf16* kb = (const LAS bf16*)ksl; float s = 0.f;
#pragma unroll 8
      for (int r = 0; r < 32; ++r) s += bf2f(kb[(part * 32 + r) * 66 + d]);
      ksum[part * 64 + d] = s; }
    {
        bf16* Kt = (bf16*)(p.ws + WS_KT) + ((size_t)bh * 256 + j * 8) * 2048; bf16* Vt = (bf16*)(p.ws + WS_VT) + ((size_t)bh * 256 + j * 8) * 2048;
        const LAS bf16* vsb = (const LAS bf16*)vs;
#pragma unroll
        for (int i = 0; i < 4; ++i) { const int q = tid + 512 * i, c8 = q >> 8, pidx = q & 255, m = pidx & 15, g = (pidx >> 4) & 3;
            { const int ks = (pidx >> 6) & 1, tt = pidx >> 7, key = 32 * c8 + 8 * (m >> 2) + 4 * tt + (m & 3); const LAS unsigned* sp = ksl + key * 33 + 16 * ks + 4 * g;
              v4u o; o.x = sp[0]; o.y = sp[1]; o.z = sp[2]; o.w = sp[3]; *(v4u*)(Kt + (size_t)c8 * 2048 + pidx * 8) = o; }
            { const int dt = pidx >> 6, d = 16 * dt + m, k0 = 32 * c8 + 8 * g; unsigned w[4];
#pragma unroll
              for (int t = 0; t < 4; ++t) w[t] = (unsigned)vsb[(k0 + 2 * t) * 66 + d] | ((unsigned)vsb[(k0 + 2 * t + 1) * 66 + d] << 16);
              v4u o; o.x = w[0]; o.y = w[1]; o.z = w[2]; o.w = w[3]; *(v4u*)(Vt + (size_t)c8 * 2048 + pidx * 8) = o; } }
    }
    __syncthreads();
    if (tid < 64) { float s = 0.f; for (int q = 0; q < 8; ++q) s += ksum[q * 64 + tid]; ((float*)(p.ws + WS_KMEAN))[(size_t)item * 64 + tid] = s * (1.f / 256.f); }
    if (tid == 0) ((float*)(p.ws + WS_KNMAX))[item] = __uint_as_float(kmx[0]);
    __syncthreads();
}
__device__ __forceinline__ int perm8(int pc, int t) { return 32 * (pc >> 2) + 16 * (t >> 2) + 4 * (pc & 3) + (t & 3); }
__device__ __forceinline__ void gdnprep_item(const Params& p, int l, int ci, LAS unsigned char* lds, int tid_in, int lane_in, int gvar = 0) {
    int tid = tid_in; asm volatile("" : "+v"(tid)); const int lane = tid & 63; (void)lane_in;
    const bf16* U = (const bf16*)(p.ws + WS_U);
    const int bh = ci >> 7, n = ci & 127, b = bh / 6, h = bh % 6;
    LAS float* qs = (LAS float*)lds; LAS float* ks = qs + 4160; LAS float* vs = ks + 4160; LAS float* Lm = vs + 4160; LAS float* Tm = Lm + 4160; LAS float* qk = Tm + 4160; LAS float* us = qk + 4160;
    LAS float* gc = us + 4160; LAS float* bet = gc + 64; LAS float* eg = bet + 64; LAS float* tmpP = eg + 64;
    LAS unsigned char* kb = lds + 120832; LAS unsigned char* qb = lds + 130048; LAS unsigned char* vT = lds + 139264; LAS unsigned char* kT = lds + 148480;
    const int wv = tid >> 6;
    const float* cw = p.in[14] + (size_t)l * 4 * 1152;
    const size_t rbase = (size_t)b * SEQ + n * 64;
    LAS bf16* raw = (LAS bf16*)Lm;
    LAS float* cws = us;
    float ga = 0.f, gb = 0.f, galog = 0.f, gdt = 0.f;
    if (tid < 64) { ga = bf2f(U[(rbase + tid) * DINP + GA0 + h]); gb = bf2f(U[(rbase + tid) * DINP + GB0 + h]); galog = p.in[15][l * 6 + h]; gdt = p.in[16][l * 6 + h]; }
    {   float cwv[2];
#pragma unroll
        for (int i = 0; i < 2; ++i) { const int t = tid + 512 * i; cwv[i] = 0.f; if (t < 768) { const int k = t / 192, cc = t % 192; cwv[i] = cw[k * 1152 + (cc >> 6) * 384 + h * 64 + (cc & 63)]; } }
        v4u rv[4];
#pragma unroll
        for (int i = 0; i < 4; ++i) { const int pi = tid + 512 * i; rv[i] = (v4u){0u, 0u, 0u, 0u};
            if (pi < 1608) { const int r = pi / 24, q = pi % 24, grp = q >> 3, pc = q & 7, tp = n * 64 - 3 + r;
                if (tp >= 0) rv[i] = *(const v4u*)(U + ((size_t)b * SEQ + tp) * DINP + GQ0 + grp * 384 + h * 64 + 8 * pc); } }
#pragma unroll
        for (int i = 0; i < 4; ++i) { const int pi = tid + 512 * i; if (pi < 1608) { const int r = pi / 24, q = pi % 24; *(LAS v4u*)(raw + r * 192 + 8 * q) = rv[i]; } }
#pragma unroll
        for (int i = 0; i < 2; ++i) { const int t = tid + 512 * i; if (t < 768) cws[t] = cwv[i]; }
    }
    __syncthreads();
    {
        const int r = tid >> 3, pt = tid & 7; float o[3][8];
#pragma unroll
        for (int grp = 0; grp < 3; ++grp) {
            const int cc = grp * 64 + pt * 8; float a[8];
#pragma unroll
            for (int t = 0; t < 8; ++t) a[t] = 0.f;
#pragma unroll
            for (int k = 0; k < 4; ++k) { const v4u rw = *(const LAS v4u*)(raw + (r + k) * 192 + cc); const f32x4 c0 = *(const LAS f32x4*)(cws + k * 192 + cc), c1 = *(const LAS f32x4*)(cws + k * 192 + cc + 4);
                a[0] += __uint_as_float(rw.x << 16) * c0[0]; a[1] += __uint_as_float(rw.x & 0xffff0000u) * c0[1]; a[2] += __uint_as_float(rw.y << 16) * c0[2]; a[3] += __uint_as_float(rw.y & 0xffff0000u) * c0[3];
                a[4] += __uint_as_float(rw.z << 16) * c1[0]; a[5] += __uint_as_float(rw.z & 0xffff0000u) * c1[1]; a[6] += __uint_as_float(rw.w << 16) * c1[2]; a[7] += __uint_as_float(rw.w & 0xffff0000u) * c1[3]; }
#pragma unroll
            for (int t = 0; t < 8; ++t) o[grp][t] = silu_f(a[t]);
        }
        if (tid < 64) {
            const float xx = ga + gdt; const float sp = xx > 20.f ? xx : log1pf(expf(xx));
            float g = -expf(galog) * sp;
#pragma unroll
            for (int o2 = 1; o2 < 64; o2 <<= 1) { const float t = __shfl_up(g, o2); if (lane >= o2) g += t; }
            gc[tid] = g; bet[tid] = sigmoid_f(gb); eg[tid] = expf(g);
        }
        float sq = 0.f, sk = 0.f;
#pragma unroll
        for (int t = 0; t < 8; ++t) { sq += o[0][t] * o[0][t]; sk += o[1][t] * o[1][t]; }
        sq += __shfl_xor(sq, 1); sq += __shfl_xor(sq, 2); sq += __shfl_xor(sq, 4); sk += __shfl_xor(sk, 1); sk += __shfl_xor(sk, 2); sk += __shfl_xor(sk, 4);
        const float rq = rsqrtf(sq + EPS) * 0.125f, rk = rsqrtf(sk + EPS);
        float qn[8], kn[8];
#pragma unroll
        for (int t = 0; t < 8; ++t) { qn[t] = o[0][t] * rq; kn[t] = o[1][t] * rk; qs[r * 65 + pt * 8 + t] = qn[t]; ks[r * 65 + pt * 8 + t] = kn[t]; vs[r * 65 + pt * 8 + t] = o[2][t]; }
        v4u w; w.x = pk2(qn[0], qn[1]); w.y = pk2(qn[2], qn[3]); w.z = pk2(qn[4], qn[5]); w.w = pk2(qn[6], qn[7]); *(LAS v4u*)(qb + r * 144 + pt * 16) = w;
        w.x = pk2(kn[0], kn[1]); w.y = pk2(kn[2], kn[3]); w.z = pk2(kn[4], kn[5]); w.w = pk2(kn[6], kn[7]); *(LAS v4u*)(kb + r * 144 + pt * 16) = w;
#pragma unroll
        for (int t = 0; t < 8; ++t) { ((LAS bf16*)kT)[(pt * 8 + t) * 72 + r] = (bf16)(pk2(kn[t], 0.f) & 0xffffu); ((LAS bf16*)vT)[(pt * 8 + t) * 72 + r] = (bf16)(pk2(o[2][t], 0.f) & 0xffffu); }
    }
    if (gvar == 1) { __syncthreads(); return; }
    __syncthreads();
    {   const int kind = wv >> 2, mt = wv & 3, n16 = lane & 15, g4 = lane >> 4;
        const LAS unsigned char* ap = (kind ? qb : kb) + (16 * mt + n16) * 144 + g4 * 16;
        const bf16x8 a0 = *(const LAS bf16x8*)ap, a1 = *(const LAS bf16x8*)(ap + 64);
#pragma unroll
        for (int nt = 0; nt < 4; ++nt) { const LAS unsigned char* bp = kb + (16 * nt + n16) * 144 + g4 * 16;
            f32x4 acc = {0.f, 0.f, 0.f, 0.f}; acc = MFMA16(a0, *(const LAS bf16x8*)bp, acc); acc = MFMA16(a1, *(const LAS bf16x8*)(bp + 64), acc);
            const int sI = 16 * nt + n16; const float gs = gc[sI];
#pragma unroll
            for (int i = 0; i < 4; ++i) { const int c = 16 * mt + 4 * g4 + i; const float dec = (sI <= c) ? expf(gc[c] - gs) : 0.f;
                if (kind == 0) { Lm[c * 65 + sI] = (sI < c) ? bet[c] * acc[i] * dec : 0.f; Tm[c * 65 + sI] = 0.f; } else qk[c * 65 + sI] = acc[i] * dec; } } }
    __syncthreads();
    if (gvar == 2) { __syncthreads(); return; }
    if (tid < 64) { const int blk = tid >> 4, cc = tid & 15; float t[16];
#pragma unroll
        for (int r = 0; r < 16; ++r) { float v = (r == cc) ? 1.f : 0.f;
#pragma unroll
            for (int j = 0; j < 16; ++j) if (j < r) v -= Lm[(16 * blk + r) * 65 + 16 * blk + j] * t[j];
            t[r] = v; }
#pragma unroll
        for (int r = 0; r < 16; ++r) Tm[(16 * blk + r) * 65 + 16 * blk + cc] = t[r]; }
    __syncthreads();
#pragma unroll
    for (int dist = 1; dist < 4; ++dist) { const int np = 4 - dist;
        for (int idx = tid; idx < np * 256; idx += 512) { const int pr = idx >> 8, r = (idx >> 4) & 15, cc = idx & 15, i = pr + dist, j = pr; float a0 = 0.f, a1 = 0.f;
            const LAS float* lp = Lm + (16 * i + r) * 65 + 16 * j; const LAS float* tp = Tm + (16 * j) * 65 + 16 * j + cc;
#pragma unroll 8
            for (int k = 0; k < 16 * dist; k += 2) { a0 += lp[k] * tp[k * 65]; a1 += lp[k + 1] * tp[(k + 1) * 65]; }
            tmpP[pr * 272 + r * 17 + cc] = a0 + a1; }
        __syncthreads();
        for (int idx = tid; idx < np * 256; idx += 512) { const int pr = idx >> 8, r = (idx >> 4) & 15, cc = idx & 15, i = pr + dist, j = pr; float a0 = 0.f, a1 = 0.f;
#pragma unroll
            for (int k = 0; k < 16; k += 2) { a0 += Tm[(16 * i + r) * 65 + 16 * i + k] * tmpP[pr * 272 + k * 17 + cc]; a1 += Tm[(16 * i + r) * 65 + 16 * i + k + 1] * tmpP[pr * 272 + (k + 1) * 17 + cc]; }
            Tm[(16 * i + r) * 65 + 16 * j + cc] = -(a0 + a1); }
        __syncthreads();
    }
    if (gvar == 3) { __syncthreads(); return; }
    {   const int c = tid >> 3, pt = tid & 7; float tb[8], tg[8];
#pragma unroll
        for (int t = 0; t < 8; ++t) { const int sI = pt * 8 + t; tb[t] = Tm[c * 65 + sI] * bet[sI]; tg[t] = tb[t] * eg[sI]; }
        v4u w; w.x = pk2(tb[0], tb[1]); w.y = pk2(tb[2], tb[3]); w.z = pk2(tb[4], tb[5]); w.w = pk2(tb[6], tb[7]); *(LAS v4u*)(kb + c * 144 + pt * 16) = w;
        w.x = pk2(tg[0], tg[1]); w.y = pk2(tg[2], tg[3]); w.z = pk2(tg[4], tg[5]); w.w = pk2(tg[6], tg[7]); *(LAS v4u*)(qb + c * 144 + pt * 16) = w; }
    __syncthreads();
    {   const int kind = wv >> 2, mt = wv & 3, n16 = lane & 15, g4 = lane >> 4;
        const LAS unsigned char* ap = (kind ? qb : kb) + (16 * mt + n16) * 144 + g4 * 16;
        const bf16x8 a0 = *(const LAS bf16x8*)ap, a1 = *(const LAS bf16x8*)(ap + 64);
        LAS float* dst = kind ? Lm : us;
#pragma unroll
        for (int nt = 0; nt < 4; ++nt) { const LAS unsigned char* bp = (kind ? kT : vT) + (16 * nt + n16) * 144 + g4 * 16;
            f32x4 acc = {0.f, 0.f, 0.f, 0.f}; acc = MFMA16(a0, *(const LAS bf16x8*)bp, acc); acc = MFMA16(a1, *(const LAS bf16x8*)(bp + 64), acc);
#pragma unroll
            for (int i = 0; i < 4; ++i) dst[(16 * mt + 4 * g4 + i) * 65 + 16 * nt + n16] = acc[i]; } }
    __syncthreads();
    { const int row = 16 * (tid >> 7) + (tid & 15), pc = 4 * ((tid >> 6) & 1) + ((tid >> 4) & 3); const size_t off = (size_t)ci * 4096 + (size_t)tid * 8;
      float v[8]; v4u o;
      const float egr = eg[row], gl = gc[63];
#pragma unroll
      for (int t = 0; t < 8; ++t) v[t] = Lm[row * 65 + perm8(pc, t)];
      o.x = pk2(v[0], v[1]); o.y = pk2(v[2], v[3]); o.z = pk2(v[4], v[5]); o.w = pk2(v[6], v[7]); *(v4u*)((bf16*)(p.ws + WS_AW) + off) = o;
#pragma unroll
      for (int t = 0; t < 8; ++t) v[t] = qk[row * 65 + perm8(pc, t)];
      o.x = pk2(v[0], v[1]); o.y = pk2(v[2], v[3]); o.z = pk2(v[4], v[5]); o.w = pk2(v[6], v[7]); *(v4u*)((bf16*)(p.ws + WS_AQK) + off) = o;
#pragma unroll
      for (int t = 0; t < 8; ++t) v[t] = qs[row * 65 + perm8(pc, t)] * egr;
      o.x = pk2(v[0], v[1]); o.y = pk2(v[2], v[3]); o.z = pk2(v[4], v[5]); o.w = pk2(v[6], v[7]); *(v4u*)((bf16*)(p.ws + WS_AQD) + off) = o;
#pragma unroll
      for (int t = 0; t < 8; ++t) { const int s = perm8(pc, t); v[t] = ks[s * 65 + row] * expf(gl - gc[s]); }
      o.x = pk2(v[0], v[1]); o.y = pk2(v[2], v[3]); o.z = pk2(v[4], v[5]); o.w = pk2(v[6], v[7]); *(v4u*)((bf16*)(p.ws + WS_AKD) + off) = o;
      const int e0 = 8 * tid, slice = e0 >> 10, mt = (e0 >> 8) & 3;
#pragma unroll
      for (int t = 0; t < 8; ++t) { const int ln = (2 * tid + (t >> 2)) & 63, i = t & 3; v[t] = us[(16 * mt + 4 * (ln >> 4) + i) * 65 + 16 * slice + (ln & 15)]; }
      o.x = pk2(v[0], v[1]); o.y = pk2(v[2], v[3]); o.z = pk2(v[4], v[5]); o.w = pk2(v[6], v[7]); *(v4u*)((bf16*)(p.ws + WS_UD) + (size_t)ci * 4096 + e0) = o;
      if (tid == 0) ((float*)(p.ws + WS_EGL))[ci] = eg[63]; }
    __syncthreads();
}

template <int VAR>
__device__ __forceinline__ void gdn_scan(const Params& p, int l, int bh, LAS unsigned char* lds, int tid, int wave, int lane) {
    constexpr int BUFB = 26624, OFF_U = 18432, OFF_EG = 3 * BUFB;
    LAS float* egls = (LAS float*)(lds + OFF_EG);
    const int ci0 = bh * 128;
    if (wave >= 4) {
        const int t = tid - 256;
        const unsigned char* src[3] = { p.ws + WS_AW, p.ws + WS_AKD, p.ws + WS_UD };
        const float* EGL = (const float*)(p.ws + WS_EGL);
        unsigned ldA[2], ldL[2]; size_t gA[2];
#pragma unroll
        for (int j = 0; j < 2; ++j) { const int q = t + 256 * j; ldA[j] = (16 * (q >> 7) + (q & 15)) * 144 + (4 * ((q >> 6) & 1) + ((q >> 4) & 3)) * 16; ldL[j] = q * 16; gA[j] = (size_t)ci0 * 8192 + q * 16; }
        v4u pf[3][6]; float pe[3] = {0.f, 0.f, 0.f};
#define SC_LOAD(S, M) do { const int mo_ = (M) < 127 ? (M) : 127; \
        _Pragma("unroll") for (int i_ = 0; i_ < 3; ++i_) _Pragma("unroll") for (int j_ = 0; j_ < 2; ++j_) pf[S][2 * i_ + j_] = *(const v4u*)(src[i_] + gA[j_] + (size_t)mo_ * 8192); \
        pe[S] = EGL[ci0 + mo_]; } while (0)
#define SC_STORE(S, BUF) do { LAS unsigned char* d_ = lds + (BUF) * BUFB; \
        _Pragma("unroll") for (int i_ = 0; i_ < 2; ++i_) _Pragma("unroll") for (int j_ = 0; j_ < 2; ++j_) *(LAS v4u*)(d_ + i_ * 9216 + ldA[j_]) = pf[S][2 * i_ + j_]; \
        _Pragma("unroll") for (int j_ = 0; j_ < 2; ++j_) *(LAS v4u*)(d_ + OFF_U + ldL[j_]) = pf[S][4 + j_]; \
        if (t == 0) egls[BUF] = pe[S]; } while (0)
        SC_LOAD(0, 0); SC_LOAD(1, 1); SC_STORE(0, 0); SC_LOAD(2, 2); SC_STORE(1, 1); SC_LOAD(0, 3); SC_LOAD(1, 4);
        __syncthreads();
#define SC_LSTEP(N, SX) do { const int n = (N); if (n < 128) { SC_STORE(SX, SX); SC_LOAD(SX, n + 5); __syncthreads(); } } while (0)
        for (int n0 = 0; n0 < 128; n0 += 3) { SC_LSTEP(n0, 2); SC_LSTEP(n0 + 1, 0); SC_LSTEP(n0 + 2, 1); }
#undef SC_LSTEP
#undef SC_LOAD
#undef SC_STORE
    } else {
        const int n16 = lane & 15, g = lane >> 4;
        unsigned char* SV = p.ws + WS_SV + (size_t)ci0 * 8192 + wave * 2048 + lane * 16;
        f32x4 S[4]; bf16x8 Sb[2];
#pragma unroll
        for (int i = 0; i < 4; ++i) S[i] = (f32x4){0.f, 0.f, 0.f, 0.f};
        Sb[0] = (bf16x8){0, 0, 0, 0, 0, 0, 0, 0}; Sb[1] = Sb[0];
        __syncthreads();
#define AFR(base, mat, mt, ks) (*(const LAS bf16x8*)((base) + (mat) * 9216 + (mt) * (16 * 144) + (ks) * 64))
        bf16x8 fa[4][2]; v2u uw[4]; float egl;
        {   const LAS unsigned char* ab = lds + (n16 * 144) + g * 16;
#pragma unroll
            for (int mt = 0; mt < 4; ++mt) { fa[mt][0] = AFR(ab, 0, mt, 0); fa[mt][1] = AFR(ab, 0, mt, 1); uw[mt] = *(const LAS v2u*)(lds + OFF_U + ((wave * 4 + mt) * 64 + lane) * 8); }
            egl = egls[0]; }
        int cb = 0;
        for (int n = 0; n < 128; ++n) {
            const int nb = (cb == 2) ? 0 : cb + 1;
            const LAS unsigned char* ab = lds + cb * BUFB + (n16 * 144) + g * 16;
            *(bf16x8*)(SV + (size_t)n * 8192) = Sb[0]; *(bf16x8*)(SV + (size_t)n * 8192 + 1024) = Sb[1];
            bf16x8 fb[4][2];
#pragma unroll
            for (int mt = 0; mt < 4; ++mt) { fb[mt][0] = AFR(ab, 1, mt, 0); fb[mt][1] = AFR(ab, 1, mt, 1); }
            f32x4 vn[4];
#pragma unroll
            for (int mt = 0; mt < 4; ++mt) {
                f32x4 uc; uc[0] = __uint_as_float(uw[mt].x << 16); uc[1] = __uint_as_float(uw[mt].x & 0xffff0000u); uc[2] = __uint_as_float(uw[mt].y << 16); uc[3] = __uint_as_float(uw[mt].y & 0xffff0000u);
                f32x4 a = {0.f, 0.f, 0.f, 0.f}; a = MFMA16(fa[mt][0], Sb[0], a); a = MFMA16(fa[mt][1], Sb[1], a); vn[mt] = uc - a; }
            bf16x8 vb[2]; vb[0] = pack8(vn[0], vn[1]); vb[1] = pack8(vn[2], vn[3]);
            const float eg_cur = egl;
            {
                const LAS unsigned char* an = lds + nb * BUFB + (n16 * 144) + g * 16;
#pragma unroll
                for (int mt = 0; mt < 4; ++mt) { fa[mt][0] = AFR(an, 0, mt, 0); fa[mt][1] = AFR(an, 0, mt, 1); uw[mt] = *(const LAS v2u*)(lds + nb * BUFB + OFF_U + ((wave * 4 + mt) * 64 + lane) * 8); }
                egl = egls[nb]; }
#pragma unroll
            for (int mt = 0; mt < 4; ++mt) { f32x4 a = S[mt] * eg_cur; a = MFMA16(fb[mt][0], vb[0], a); a = MFMA16(fb[mt][1], vb[1], a); S[mt] = a; }
            Sb[0] = pack8(S[0], S[1]); Sb[1] = pack8(S[2], S[3]);
            cb = nb;
            __syncthreads();
        }
#undef AFR
    }
    __syncthreads();
}
struct OphRegs { bf16x8 Sb[2], aw[4][2], aq[2][2], ak[2][2]; v2u un[4]; v4u zv; };
__device__ __forceinline__ void gdn_out_load(const Params& p, int ci, OphRegs& R, int tid, int wave, int lane) {
    const bf16* U = (const bf16*)(p.ws + WS_U);
    const int bh = ci >> 7, n = ci & 127, b = bh / 6, h = bh % 6;
    const int sl = wave & 3, hm = wave >> 2, n16 = lane & 15, g = lane >> 4;
    const size_t co = (size_t)ci * 4096;
    const bf16* SV = (const bf16*)(p.ws + WS_SV) + co; const bf16* AW = (const bf16*)(p.ws + WS_AW) + co; const bf16* AQD = (const bf16*)(p.ws + WS_AQD) + co;
    const bf16* AQK = (const bf16*)(p.ws + WS_AQK) + co; const bf16* UD = (const bf16*)(p.ws + WS_UD) + co;
    const int zrow = tid >> 3, zpc = tid & 7; const size_t grow = (size_t)b * SEQ + n * 64 + zrow;
    R.zv = *(const v4u*)(U + grow * DINP + GZ0 + h * 64 + 8 * zpc);
#pragma unroll
    for (int ks = 0; ks < 2; ++ks) R.Sb[ks] = *(const bf16x8*)(SV + ((sl * 2 + ks) * 64 + lane) * 8);
#pragma unroll
    for (int mt = 0; mt < 4; ++mt) { R.un[mt] = *(const v2u*)(UD + ((sl * 4 + mt) * 64 + lane) * 4);
#pragma unroll
        for (int ks = 0; ks < 2; ++ks) R.aw[mt][ks] = *(const bf16x8*)(AW + (((mt * 2 + ks) * 4 + g) * 16 + n16) * 8); }
#pragma unroll
    for (int mi = 0; mi < 2; ++mi)
#pragma unroll
        for (int ks = 0; ks < 2; ++ks) { const int off = ((((2 * hm + mi) * 2 + ks) * 4 + g) * 16 + n16) * 8; R.aq[mi][ks] = *(const bf16x8*)(AQD + off); R.ak[mi][ks] = *(const bf16x8*)(AQK + off); }
}
__device__ __forceinline__ void gdn_out_compute(const Params& p, int l, int ci, const OphRegs& R, LAS unsigned char* lds, int tid, int wave, int lane) {
    bf16* Y = (bf16*)(p.ws + WS_Y);
    const int bh = ci >> 7, n = ci & 127, b = bh / 6, h = bh % 6;
    const int sl = wave & 3, hm = wave >> 2, n16 = lane & 15, g = lane >> 4;
    LAS float* Ot = (LAS float*)lds;
    const int zrow = tid >> 3, zpc = tid & 7; const size_t grow = (size_t)b * SEQ + n * 64 + zrow;
    f32x4 vn[4];
#pragma unroll
    for (int mt = 0; mt < 4; ++mt) { f32x4 uc; uc[0] = __uint_as_float(R.un[mt].x << 16); uc[1] = __uint_as_float(R.un[mt].x & 0xffff0000u); uc[2] = __uint_as_float(R.un[mt].y << 16); uc[3] = __uint_as_float(R.un[mt].y & 0xffff0000u);
        f32x4 a = {0.f, 0.f, 0.f, 0.f}; a = MFMA16(R.aw[mt][0], R.Sb[0], a); a = MFMA16(R.aw[mt][1], R.Sb[1], a); vn[mt] = uc - a; }
    bf16x8 vb[2]; vb[0] = pack8(vn[0], vn[1]); vb[1] = pack8(vn[2], vn[3]);
#pragma unroll
    for (int mi = 0; mi < 2; ++mi) { f32x4 a = {0.f, 0.f, 0.f, 0.f}; a = MFMA16(R.aq[mi][0], R.Sb[0], a); a = MFMA16(R.aq[mi][1], R.Sb[1], a); a = MFMA16(R.ak[mi][0], vb[0], a); a = MFMA16(R.ak[mi][1], vb[1], a);
#pragma unroll
        for (int i = 0; i < 4; ++i) Ot[(16 * (2 * hm + mi) + 4 * g + i) * 65 + 16 * sl + n16] = a[i]; }
    __syncthreads();
    {   float v[8]; float ss = 0.f;
#pragma unroll
        for (int t = 0; t < 8; ++t) { v[t] = Ot[zrow * 65 + 8 * zpc + t]; ss += v[t] * v[t]; }
        ss += __shfl_xor(ss, 1); ss += __shfl_xor(ss, 2); ss += __shfl_xor(ss, 4);
        const float rstd = rsqrtf(ss * (1.f / 64.f) + EPS); const LAS float* ng = Ot + 4160 + 8 * zpc;
        const unsigned zw[4] = {R.zv.x, R.zv.y, R.zv.z, R.zv.w}; v4u o;
        unsigned ow[4];
#pragma unroll
        for (int c = 0; c < 4; ++c) { const float za = __uint_as_float(zw[c] << 16), zb = __uint_as_float(zw[c] & 0xffff0000u);
            ow[c] = pk2(v[2 * c] * rstd * ng[2 * c] * silu_f(za), v[2 * c + 1] * rstd * ng[2 * c + 1] * silu_f(zb)); }
        o.x = ow[0]; o.y = ow[1]; o.z = ow[2]; o.w = ow[3];
        *(v4u*)(Y + grow * DM + 640 + h * 64 + 8 * zpc) = o; }
    __syncthreads();
}
__device__ __forceinline__ void gdn_out_phase(const Params& p, int l, int it0, int step, LAS unsigned char* lds, int tid, int wave, int lane) {
    OphRegs RA, RB;
    if (tid < 64) ((LAS float*)lds)[4160 + tid] = p.in[17][l * 64 + tid];
    if (it0 < 1536) gdn_out_load(p, it0, RA, tid, wave, lane);
    for (int it = it0; it < 1536; it += 2 * step) {
        const int it1 = it + step, it2 = it + 2 * step;
        if (it1 < 1536) gdn_out_load(p, it1, RB, tid, wave, lane);
        gdn_out_compute(p, l, it, RA, lds, tid, wave, lane);
        if (it1 < 1536) {
            if (it2 < 1536) gdn_out_load(p, it2, RA, tid, wave, lane);
            gdn_out_compute(p, l, it1, RB, lds, tid, wave, lane);
        }
    }
}

constexpr float MOBA_C2 = 0.125f * 1.4426950408889634f;
#ifndef MB_NC
#define MB_NC 8
#endif
constexpr int MB_PR = 68;
constexpr int MB_P = 0, MB_LSEL = 104448, MB_MSH = 107520, MB_CNT = 108544, MB_TST = 108672, MB_LIST = 108928, MB_QS = 124800, MB_KMAX = 161664;
template <bool OWN>
__device__ __forceinline__ void moba_task(const bf16* KT, const bf16* VT, bf16* Y, int b, int h, int bh, int qb, int j, int gi, int nv, int nsel, int wave, int lane, LAS unsigned char* lds) {
    int ln_ = lane; asm volatile("" : "+v"(ln_));
    const int n = ln_ & 15, g = ln_ >> 4;
    const LAS float* msh = (const LAS float*)(lds + MB_MSH); LAS float* lsel = (LAS float*)(lds + MB_LSEL); const LAS unsigned short* list = (const LAS unsigned short*)(lds + MB_LIST);
    const LAS unsigned char* Qs = lds + MB_QS;
    int ql[2], sl[2]; bool valid[2]; float msl[2];
#pragma unroll
    for (int nt = 0; nt < 2; ++nt) {
        const int slot = 16 * nt + n;
        if (OWN) { ql[nt] = 32 * wave + slot; sl[nt] = 0; valid[nt] = true; }
        else { valid[nt] = slot < nv; const unsigned e = list[j * 256 + 32 * gi + (valid[nt] ? slot : 0)]; ql[nt] = e & 255; sl[nt] = e >> 8; }
        msl[nt] = msh[ql[nt]];
    }
    const int nch = OWN ? (wave + 1) : 8;
    const bf16* kbase = KT + ((size_t)bh * 256 + j * 8) * 2048 + g * 128 + n * 8;
    const bf16* vbase = VT + ((size_t)bh * 256 + j * 8) * 2048 + g * 128 + n * 8;
    f32x4 O[4][2]; float ls[2] = {0.f, 0.f};
#pragma unroll
    for (int dt = 0; dt < 4; ++dt) { O[dt][0] = (f32x4){0.f, 0.f, 0.f, 0.f}; O[dt][1] = O[dt][0]; }
#pragma unroll 1
    for (int c0 = 0; c0 < nch; c0 += MB_NC) {
        bf16x8 pb[MB_NC][2];
        {   bf16x8 kf[MB_NC][2][2];
#pragma unroll
            for (int cc = 0; cc < MB_NC; ++cc) { const int c_ = (c0 + cc) < nch ? (c0 + cc) : nch - 1;
#pragma unroll
                for (int tt = 0; tt < 2; ++tt) { const bf16* kp_ = kbase + (size_t)c_ * 2048 + tt * 1024; kf[cc][tt][0] = *(const bf16x8*)kp_; kf[cc][tt][1] = *(const bf16x8*)(kp_ + 512); } }
            bf16x8 qf[2][2];
#pragma unroll
            for (int nt = 0; nt < 2; ++nt) { qf[nt][0] = *(const LAS bf16x8*)(Qs + ql[nt] * 144 + g * 16); qf[nt][1] = *(const LAS bf16x8*)(Qs + ql[nt] * 144 + 64 + g * 16); }
#pragma unroll
            for (int cc = 0; cc < MB_NC; ++cc) {
                const int kc = c0 + cc;
#pragma unroll
                for (int nt = 0; nt < 2; ++nt) {
                    f32x4 s[2];
#pragma unroll
                    for (int tt = 0; tt < 2; ++tt) { f32x4 a = {-msl[nt], -msl[nt], -msl[nt], -msl[nt]}; a = MFMA16(kf[cc][tt][0], qf[nt][0], a); a = MFMA16(kf[cc][tt][1], qf[nt][1], a); s[tt] = a; }
#pragma unroll
                    for (int tt = 0; tt < 2; ++tt)
#pragma unroll
                        for (int i = 0; i < 4; ++i) { float pv = __builtin_amdgcn_exp2f(s[tt][i]);
                            if (OWN) { if (32 * kc + 8 * g + 4 * tt + i > ql[nt]) pv = 0.f; }
                            if (OWN) { if (kc >= nch) pv = 0.f; }
                            s[tt][i] = pv; ls[nt] += pv; }
                    pb[cc][nt] = pack8(s[0], s[1]);
                }
            }
        }
        {   bf16x8 vf[MB_NC][4];
#pragma unroll
            for (int cc = 0; cc < MB_NC; ++cc) { const int c_ = (c0 + cc) < nch ? (c0 + cc) : nch - 1;
#pragma unroll
                for (int dt = 0; dt < 4; ++dt) vf[cc][dt] = *(const bf16x8*)(vbase + (size_t)c_ * 2048 + dt * 512); }
#pragma unroll
            for (int cc = 0; cc < MB_NC; ++cc)
#pragma unroll
                for (int dt = 0; dt < 4; ++dt) { O[dt][0] = MFMA16(vf[cc][dt], pb[cc][0], O[dt][0]); O[dt][1] = MFMA16(vf[cc][dt], pb[cc][1], O[dt][1]); }
        }
    }
#pragma unroll
    for (int nt = 0; nt < 2; ++nt) {
        float l = ls[nt]; l += __shfl_xor(l, 16); l += __shfl_xor(l, 32);
        if (OWN) {
            for (int sidx = 0; sidx < nsel; ++sidx) {
                l += lsel[sidx * 256 + ql[nt]];
#pragma unroll
                for (int dt = 0; dt < 4; ++dt) { const v2u w = *(const LAS v2u*)(lds + MB_P + ((sidx * 256 + ql[nt]) * MB_PR + 16 * dt + 4 * g) * 2);
                    O[dt][nt][0] += __uint_as_float(w.x << 16); O[dt][nt][1] += __uint_as_float(w.x & 0xffff0000u); O[dt][nt][2] += __uint_as_float(w.y << 16); O[dt][nt][3] += __uint_as_float(w.y & 0xffff0000u); }
            }
            const float inv = 1.f / l;
            bf16* yp = Y + ((size_t)b * SEQ + qb * 256 + ql[nt]) * DM + 256 + h * 64 + 4 * g;
#pragma unroll
            for (int dt = 0; dt < 4; ++dt) { v2u w; w.x = pk2(O[dt][nt][0] * inv, O[dt][nt][1] * inv); w.y = pk2(O[dt][nt][2] * inv, O[dt][nt][3] * inv); *(v2u*)(yp + 16 * dt) = w; }
        } else if (valid[nt]) {
#pragma unroll
            for (int dt = 0; dt < 4; ++dt) { v2u w; w.x = pk2(O[dt][nt][0], O[dt][nt][1]); w.y = pk2(O[dt][nt][2], O[dt][nt][3]);
                *(LAS v2u*)(lds + MB_P + ((sl[nt] * 256 + ql[nt]) * MB_PR + 16 * dt + 4 * g) * 2) = w; }
            if (g == 0) lsel[sl[nt] * 256 + ql[nt]] = l;
        }
    }
}
__device__ __forceinline__ void moba_unit(const Params& p, int bh, int qb, LAS unsigned char* lds, int tid, int wave, int lane, int mvar = 0) {
    const bf16* U = (const bf16*)(p.ws + WS_U); const bf16* VT = (const bf16*)(p.ws + WS_VT); const bf16* KT = (const bf16*)(p.ws + WS_KT); bf16* Y = (bf16*)(p.ws + WS_Y);
    const int b = bh / 6, h = bh % 6;
    LAS float* msh = (LAS float*)(lds + MB_MSH); LAS float* kms = (LAS float*)(lds + MB_P);
    LAS int* cnt = (LAS int*)(lds + MB_CNT); LAS int* tstart = (LAS int*)(lds + MB_TST); LAS unsigned short* list = (LAS unsigned short*)(lds + MB_LIST); LAS unsigned char* Qs = lds + MB_QS;
    const float* kmean = (const float*)(p.ws + WS_KMEAN) + (size_t)bh * 32 * 64; const float* knmax = (const float*)(p.ws + WS_KNMAX) + bh * 32;
    const size_t qrow0 = (size_t)b * SEQ + qb * 256;
    {   v4u qv4[4];
#pragma unroll
        for (int i = 0; i < 4; ++i) { const int pi = tid + 512 * i; qv4[i] = *(const v4u*)(U + (qrow0 + (pi >> 3)) * DINP + MQ0 + h * 64 + 8 * (pi & 7)); }
        float km4[4];
#pragma unroll
        for (int i = 0; i < 4; ++i) { const int idx = tid + 512 * i; km4[i] = (idx < qb * 64) ? kmean[idx] : 0.f; }
        float kn = (tid < 32 && tid <= qb) ? knmax[tid] : 0.f;
        if (tid < 32) cnt[tid] = 0;
#pragma unroll
        for (int i = 0; i < 4; ++i) { const int idx = tid + 512 * i; if (idx < 31 * 64) kms[idx] = km4[i]; }
#pragma unroll
        for (int i = 0; i < 4; ++i) { const int pi = tid + 512 * i; const unsigned qw[4] = {qv4[i].x, qv4[i].y, qv4[i].z, qv4[i].w}; v4u o;
            unsigned ow[4];
#pragma unroll
            for (int t = 0; t < 4; ++t) ow[t] = pk2(__uint_as_float(qw[t] << 16) * MOBA_C2, __uint_as_float(qw[t] & 0xffff0000u) * MOBA_C2);
            o.x = ow[0]; o.y = ow[1]; o.z = ow[2]; o.w = ow[3]; *(LAS v4u*)(Qs + (pi >> 3) * 144 + (pi & 7) * 16) = o; }
        if (tid < 64) {
#pragma unroll
            for (int o = 1; o < 64; o <<= 1) kn = fmaxf(kn, __shfl_xor(kn, o));
            if (tid == 0) *(LAS float*)(lds + MB_KMAX) = kn; }
    }
    __syncthreads();
    const float kmax = *(const LAS float*)(lds + MB_KMAX);
    {
        const int q = tid >> 1, hf = tid & 1;
        float qv[64]; float qn2 = 0.f;
#pragma unroll
        for (int c8 = 0; c8 < 8; ++c8) { const v4u w = *(const LAS v4u*)(Qs + q * 144 + c8 * 16);
            qv[8 * c8 + 0] = __uint_as_float(w.x << 16); qv[8 * c8 + 1] = __uint_as_float(w.x & 0xffff0000u); qv[8 * c8 + 2] = __uint_as_float(w.y << 16); qv[8 * c8 + 3] = __uint_as_float(w.y & 0xffff0000u);
            qv[8 * c8 + 4] = __uint_as_float(w.z << 16); qv[8 * c8 + 5] = __uint_as_float(w.z & 0xffff0000u); qv[8 * c8 + 6] = __uint_as_float(w.w << 16); qv[8 * c8 + 7] = __uint_as_float(w.w & 0xffff0000u); }
#pragma unroll
        for (int d = 0; d < 64; ++d) qn2 += qv[d] * qv[d];
        float v1 = -INFINITY, v2 = -INFINITY, v3 = -INFINITY; int i1 = -1, i2 = -1, i3 = -1;
        for (int jj = hf; jj < qb; jj += 2) { float sc = 0.f; const LAS f32x4* kr = (const LAS f32x4*)(kms + jj * 64);
#pragma unroll
            for (int d4 = 0; d4 < 16; ++d4) { const f32x4 kv = kr[d4]; sc += (qv[4 * d4] * kv[0] + qv[4 * d4 + 1] * kv[1]) + (qv[4 * d4 + 2] * kv[2] + qv[4 * d4 + 3] * kv[3]); }
            if (sc > v1) { v3 = v2; i3 = i2; v2 = v1; i2 = i1; v1 = sc; i1 = jj; } else if (sc > v2) { v3 = v2; i3 = i2; v2 = sc; i2 = jj; } else if (sc > v3) { v3 = sc; i3 = jj; } }
        float pvv[3]; int pii[3];
        pvv[0] = __shfl_xor(v1, 1); pvv[1] = __shfl_xor(v2, 1); pvv[2] = __shfl_xor(v3, 1); pii[0] = __shfl_xor(i1, 1); pii[1] = __shfl_xor(i2, 1); pii[2] = __shfl_xor(i3, 1);
#pragma unroll
        for (int t = 0; t < 3; ++t) { const float sc = pvv[t]; const int jj = pii[t];
            if (jj >= 0) {
                if (sc > v1 || (sc == v1 && jj < i1)) { v3 = v2; i3 = i2; v2 = v1; i2 = i1; v1 = sc; i1 = jj; }
                else if (sc > v2 || (sc == v2 && jj < i2)) { v3 = v2; i3 = i2; v2 = sc; i2 = jj; }
                else if (sc > v3 || (sc == v3 && jj < i3)) { v3 = sc; i3 = jj; } } }
        if (hf == 0) {
            if (i1 >= 0) { const int pos = __hip_atomic_fetch_add(&cnt[i1], 1, __ATOMIC_RELAXED, __HIP_MEMORY_SCOPE_WORKGROUP); list[i1 * 256 + pos] = (unsigned short)q; }
            if (i2 >= 0) { const int pos = __hip_atomic_fetch_add(&cnt[i2], 1, __ATOMIC_RELAXED, __HIP_MEMORY_SCOPE_WORKGROUP); list[i2 * 256 + pos] = (unsigned short)(q | 256); }
            if (i3 >= 0) { const int pos = __hip_atomic_fetch_add(&cnt[i3], 1, __ATOMIC_RELAXED, __HIP_MEMORY_SCOPE_WORKGROUP); list[i3 * 256 + pos] = (unsigned short)(q | 512); }
            msh[q] = sqrtf(qn2) * kmax;
        }
    }
    __syncthreads();
    LAS unsigned short* ttab = (LAS unsigned short*)tstart;
    if (tid < 64) { const int ng = (tid < qb) ? ((cnt[tid] + 31) >> 5) : 0; int inc = ng;
#pragma unroll
        for (int o = 1; o < 64; o <<= 1) { const int v = __shfl_up(inc, o); if (lane >= o) inc += v; }
        const int st = inc - ng;
        for (int gi = 0; gi < ng; ++gi) ttab[st + gi] = (unsigned short)(tid | (gi << 8));
        if (tid == 63) ttab[127] = (unsigned short)inc; }
    __syncthreads();
    const int ntask = ttab[127];
    for (int t = wave; t < (mvar == 1 ? 0 : ntask); t += 8) {
        const unsigned te = ttab[t]; const int jj = te & 255, gi = te >> 8; int nv = cnt[jj] - 32 * gi; nv = nv > 32 ? 32 : nv;
        moba_task<false>(KT, VT, Y, b, h, bh, qb, jj, gi, nv, 0, wave, lane, lds);
    }
    __syncthreads();
    moba_task<true>(KT, VT, Y, b, h, bh, qb, qb, 0, 32, qb < 3 ? qb : 3, wave, lane, lds);
    __syncthreads();
}

__device__ __forceinline__ void phase_final(const Params& p, int wave, int lane) {
    const int gw = blockIdx.x * 8 + wave, NGW = gridDim.x * 8; const float* rs = (const float*)(p.ws + WS_RS) + 6 * MTOK; const float* fg = p.in[23];
    f32x4 gv[4];
#pragma unroll
    for (int j = 0; j < 4; ++j) gv[j] = *((const f32x4*)fg + lane + 64 * j);
    for (int row0 = gw; row0 < MTOK; row0 += 4 * NGW) {
        f32x4 v[4][4]; float rstd[4];
#pragma unroll
        for (int rr = 0; rr < 4; ++rr) { const int row = (row0 + rr * NGW) < MTOK ? (row0 + rr * NGW) : row0; rstd[rr] = rsqrtf(rs[row] * (1.f / DM) + EPS); const f32x4* o = (const f32x4*)(p.out + (size_t)row * DM) + lane;
#pragma unroll
            for (int j = 0; j < 4; ++j) v[rr][j] = o[64 * j]; }
#pragma unroll
        for (int rr = 0; rr < 4; ++rr) { const int row = row0 + rr * NGW; if (row < MTOK) { f32x4* o = (f32x4*)(p.out + (size_t)row * DM) + lane;
#pragma unroll
            for (int j = 0; j < 4; ++j) o[64 * j] = v[rr][j] * rstd[rr] * gv[j]; } }
    }
}

__global__ void __launch_bounds__(512) fwd(Params p) {
    extern __shared__ __attribute__((aligned(16))) unsigned char lds_raw[];
    LAS unsigned char* lds = (LAS unsigned char*)lds_raw;
    cg::grid_group grid = cg::this_grid();
    const int G = gridDim.x, bx = blockIdx.x;
    if (threadIdx.x < 16) ((volatile LAS unsigned*)(lds + LDS_BARST))[threadIdx.x] = 0u;
    __syncthreads();
    XcdBarrier xbar = xcd_barrier_post((unsigned*)(p.ws + WS_BAR), (volatile LAS unsigned*)(lds + LDS_BARST));
#define GRID_SYNC() do { if (MK_MULTI) {} else if (first_sync) { grid.sync(); first_sync = false; } else xcd_barrier(xbar); } while (0)
    bool first_sync = true;
    bool rep_done = false; (void)rep_done;
#ifdef PROBE_EXTRA_SYNCS
    for (int i = 0; i < PROBE_EXTRA_SYNCS; ++i) GRID_SYNC();
#endif
#ifndef PROBE_SKIP
#define PROBE_SKIP 0
#endif
    for (int ph = p.ph_lo; ph < p.ph_hi; ++ph) {
        if (ph == 11 && G == 256) continue;
        int tid = threadIdx.x; asm volatile("" : "+v"(tid));
        const int lane = tid & 63, wave = __builtin_amdgcn_readfirstlane(tid >> 6);
        unsigned char* ws = p.ws; asm volatile("" : "+s"(ws));
        if (ph == 0) {
#ifndef NO_PRE
 phase_pre(p, tid, wave, lane);
#endif
}
        else if (ph == NPH - 1) phase_final(p, wave, lane);
        else {
            const int l = (ph - 1) / 10, s0_ = (ph - 1) % 10; const int s = s0_ < 6 ? s0_ : (s0_ == 6 ? 99 : s0_ - 1);
            float* rs = (float*)(ws + WS_RS); const float* mod = (const float*)(ws + WS_MOD) + (l * 2) * 9216; const float* bias = (const float*)(ws + WS_BIAS) + l * BIAS_L;
            unsigned char* wb = ws + WS_W;
            if (s == 0) {
#ifndef NO_CVT
 phase_cvt(p, l, lds, wave, lane, 0, (G != 256) ? 5312 : (l == 0 ? 2048 : 0), bx * 8 + wave, G * 8);
#endif
}
            else if (s == 1 || s == 7) {
                pg8::Gemm g{(const bf16*)(ws + WS_XB), (const bf16*)(wb + (s == 1 ? W_1GU : W_2GU)), MTOK, NGU, DM, (size_t)NGU * DM * 2};
                pg8::StaticOrder S; S.init(MTOK, NGU, G, bx);
                EpiGU E{(bf16*)(ws + WS_U), rs + (3 * l + (s == 1 ? 0 : 2)) * MTOK, bias + (s == 1 ? 0 : 2 * NGU + 2 * DINP)};
#ifndef NO_GU
                pg8::gemm_phase<EpiGU, pg8::StaticOrder, true, true>(lds, g, S, E, tid);
                if (s == 1 && G == 256 && bx >= 128) { __syncthreads(); phase_cvt(p, l, lds, wave, lane, l == 0 ? 2048 : 2112, 5312, (bx - 128) * 8 + wave, 128 * 8); }
#endif
            } else if (s == 2 || s == 6 || s == 8) {
                const int K = (s == 6) ? DM : FF;
                pg8::Gemm g{(const bf16*)(ws + (s == 6 ? WS_Y : WS_U)), (const bf16*)(wb + (s == 2 ? W_D1 : (s == 6 ? W_OUT : W_D2))), MTOK, DM, K, 0};
                pg8::StaticOrder S; S.init(MTOK, DM, G, bx);
                EpiRes E{(l == 0 && s == 2) ? p.in[0] : (const float*)p.out, p.out, (bf16*)(ws + WS_XB), rs + (3 * l + (s == 2 ? 1 : (s == 6 ? 2 : 3))) * MTOK, mod + (s == 2 ? 2048 : (s == 6 ? 5120 : 8192)), (s == 6) ? 1.0f : 0.5f};
#ifndef NO_RES
                pg8::gemm_phase<EpiRes, pg8::StaticOrder, true, true>(lds, g, S, E, tid);
#endif
            } else if (s == 3) {
                pg8::Gemm g{(const bf16*)(ws + WS_XB), (const bf16*)(wb + W_IN), MTOK, DINP, DM, (size_t)DINP * DM * 2};
                pg8::StaticOrder S; S.init(MTOK, DINP, G, bx);
                EpiIn E{(bf16*)(ws + WS_U), rs + (3 * l + 1) * MTOK, bias + 2 * NGU, (const float*)(ws + WS_ROPE)};
#ifndef NO_IN
                pg8::gemm_phase<EpiIn, pg8::StaticOrder, true, true>(lds, g, S, E, tid);
                if (l + 1 < 2 && G == 256 && bx >= 64) { __syncthreads(); phase_cvt(p, l + 1, lds, wave, lane, 0, 2112, (bx - 64) * 8 + wave, 192 * 8); }
#endif
            } else if (s == 4) {
#ifndef NO_GPREP
#ifdef PROBE_GPREP_VAR
                if (!rep_done) { for (int it = bx; it < 1536; it += G) gdnprep_item(p, l, it, lds, tid, lane, PROBE_GPREP_VAR); } else
#endif
                if (!(rep_done && (PROBE_SKIP & 1))) for (int it = bx; it < 1536; it += G) gdnprep_item(p, l, it, lds, tid, lane);
#endif
#ifndef NO_MPREP
#ifdef PROBE_GPREP_VAR
                if (rep_done)
#endif
                if (!(rep_done && (PROBE_SKIP & 4))) for (int it = bx; it < 384; it += G) mobaprep_item(p, it, lds, tid);
#endif
            } else if (s == 99) {
                gdn_out_phase(p, l, bx, G, lds, tid, wave, lane);
            } else if (s == 5) {
                int cv0 = 0, cvn = 0, cvs = 1;
                if (bx < 12) {
#ifndef NO_SCAN
#ifdef PROBE_SCAN_VAR
 if (!rep_done) gdn_scan<PROBE_SCAN_VAR>(p, l, bx, lds, tid, wave, lane); else
#endif
#ifdef PROBE_MOBA_VAR
 if (rep_done)
#endif
 if (!(rep_done && (PROBE_SKIP & 8))) gdn_scan<0>(p, l, bx, lds, tid, wave, lane);
#endif
}
                else if (G == 256) {
                    const int x = bx & 7, first = (x < 4) ? x + 16 : x + 8, nblk = (256 - first + 7) >> 3, lidx = (bx - first) >> 3;
                    unsigned ulist = 0u; int nu = 0;
                    if (lidx < 32) { ulist |= (unsigned)(x * 32 + 31 - lidx) << (10 * nu); ++nu; }
                    { const int i = nblk - 1 - lidx; if (i >= 0 && i < 16) { ulist |= (unsigned)((8 + (x >> 1)) * 32 + 31 - 2 * i - (x & 1)) << (10 * nu); ++nu; } }
                    { const int k = nblk + (nblk - 17 - lidx); if (lidx <= nblk - 17 && k >= nblk && k < 32) { ulist |= (unsigned)(x * 32 + 31 - k) << (10 * nu); ++nu; } }
                    ulist = __builtin_amdgcn_readfirstlane(ulist); nu = __builtin_amdgcn_readfirstlane(nu);
                    for (int ui = 0; ui < nu; ++ui) {
                        const int uu = (ulist >> (10 * ui)) & 1023, cbh = uu >> 5, cqb = uu & 31;
#ifndef NO_MOBA
#ifdef PROBE_MOBA_VAR
                        if (!rep_done) moba_unit(p, cbh, cqb, lds, tid, wave, lane, PROBE_MOBA_VAR); else
#endif
                        if (!(rep_done && (PROBE_SKIP & 16))) moba_unit(p, cbh, cqb, lds, tid, wave, lane);
#endif
                    }
                    {   const int ns = nblk - 18;
                        if (lidx < ns) { cv0 = 32 * x + 2 * lidx; cvn = 2; }
                        else { const int r = 2 * ns + (lidx - (nblk - 16)); if (lidx >= nblk - 16 && r < 32) { cv0 = 32 * x + r; cvn = 1; } } }
                } else { for (int it = bx - 12; it < 384; it += G - 12) moba_unit(p, it % 12, 31 - it / 12, lds, tid, wave, lane);
                    cv0 = bx - 12; cvs = G - 12; cvn = (cv0 < 256) ? (256 - cv0 + cvs - 1) / cvs : 0; }
                for (int k = 0; k < cvn; ++k) conv_item(p, l, cv0 + k * cvs, (LAS float*)lds, tid, wave, lane);
            }
        }
#if defined(PROBE_REP_S)
        if (ph > 0 && ph < NPH - 1 && (ph - 1) % 10 == PROBE_REP_S && !rep_done) { rep_done = true; GRID_SYNC(); --ph; continue; }
        rep_done = false;
#endif
        if (ph + 1 < p.ph_hi) GRID_SYNC();
    }
}

extern "C" void kernel_launch(void* const* d_in, const int* in_sizes, int n_in, void* d_out, int out_size, void* d_ws, size_t ws_size, hipStream_t stream) {
    static int grid = 0;
    if (grid == 0) {
        if (n_in != 24 || out_size != MTOK * DM || ws_size < WS_END) { fprintf(stderr, "kernel_launch: unexpected shapes (n_in %d out %d ws %zu)\n", n_in, out_size, ws_size); grid = -1; return; }
        int dev = 0, cus = 0, per_cu = 0;
        hipGetDevice(&dev); hipDeviceGetAttribute(&cus, hipDeviceAttributeMultiprocessorCount, dev);
        hipFuncSetAttribute((const void*)fwd, hipFuncAttributeMaxDynamicSharedMemorySize, LDS_BYTES);
        hipOccupancyMaxActiveBlocksPerMultiprocessor(&per_cu, (const void*)fwd, 512, LDS_BYTES);
        if (per_cu < 1) per_cu = 1;
        grid = cus * per_cu; if (grid > 256) grid = 256;
        (void)hipGetLastError();
    }
    if (grid < 0) return;
    hipMemsetAsync(d_ws, 0, CTL_ZERO, stream);
    Params p{};
    for (int i = 0; i < 24; ++i) p.in[i] = (const float*)d_in[i];
    p.out = (float*)d_out; p.ws = (unsigned char*)d_ws;
#if MK_MULTI
    for (int ph = 0; ph < NPH; ++ph) { p.ph_lo = ph; p.ph_hi = ph + 1; hipLaunchKernelGGL(fwd, dim3(grid), dim3(512), LDS_BYTES, stream, p); }
#else
    p.ph_lo = 0; p.ph_hi = NPH;
    void* args[] = {&p};
    hipError_t e = hipLaunchCooperativeKernel((const void*)fwd, dim3(grid), dim3(512), args, LDS_BYTES, stream);
    if (e != hipSuccess) fprintf(stderr, "cooperative launch failed: %s (grid %d)\n", hipGetErrorString(e), grid);
#endif
}
```

```cpp
#include <hip/hip_runtime.h>
#include <hip/hip_cooperative_groups.h>
#include <cstdio>
#include <cstdint>
#include <cmath>
namespace cg = cooperative_groups;
#define MB_NC 4
namespace pg8 {
#define PG8_LAS __attribute__((address_space(3)))
typedef unsigned short bf16_t;
typedef short bf16x8 __attribute__((ext_vector_type(8)));
typedef float f32x4 __attribute__((ext_vector_type(4)));
typedef unsigned u32x4 __attribute__((ext_vector_type(4)));
constexpr int BM = 256, BK = 64, HALF = 128, HTB = HALF * BK * 2  , STAGE_BYTES = 8 * HTB, NXCD = 8, WGM = 8;

__host__ __device__ __forceinline__ int lds_byte(int r, int c) { const int st = (r >> 4) * 2 + (c >> 5), rr = r & 15, cc = c & 31, ob = rr * 64 + cc * 2; return st * 1024 + (ob ^ (((ob >> 9) & 1) << 5)); }
__host__ __device__ __forceinline__ void stage_rc(int b, int& R, int& C) { const int st = b / 1024, sb = b % 1024, swz = sb ^ (((sb >> 9) & 1) << 5); R = (st >> 1) * 16 + swz / 64; C = (st & 1) * 32 + (swz % 64) / 2; }
__host__ __device__ __forceinline__ int perm32(int rho) { const int n = rho >> 4, i = rho & 15; return 8 * (i >> 2) + 4 * n + (i & 3); }

struct Unit { int pm, pn; };
struct Gemm { const bf16_t* A; const bf16_t* Bt; int M, N, K; size_t bstride; };

struct StaticOrder {
    int nM, nN, nwg, G, c;
    __host__ __device__ void init(int M, int N, int G_, int c_) { nM = M / BM; nN = N / BM; nwg = nM * nN; G = G_; c = c_; }
    __host__ __device__ bool next(int i, Unit& u) const {
        const long L = (long)i * G + c; if (L >= nwg) return false;
        int wgid = (int)L; { const int q = nwg / NXCD, r = nwg % NXCD, xcd = wgid % NXCD, off = wgid / NXCD; wgid = (xcd < r ? xcd * (q + 1) : r * (q + 1) + (xcd - r) * q) + off; }
        const int nig = WGM * nN, gid = wgid / nig, fm = gid * WGM, gsz = (nM - fm) < WGM ? (nM - fm) : WGM;
        u.pm = fm + ((wgid % nig) % gsz); u.pn = (wgid % nig) / gsz; return true;
    }
    __device__ __forceinline__ void a_ready(const Unit&) const {}
    __device__ __forceinline__ void done(const Unit&) const {}
};

__device__ __forceinline__ unsigned cvt_pk_bf16(float lo, float hi) { unsigned r; asm volatile("v_cvt_pk_bf16_f32 %0, %1, %2" : "=v"(r) : "v"(lo), "v"(hi)); return r; }
typedef float f32x2 __attribute__((ext_vector_type(2)));
typedef float f32x2 __attribute__((ext_vector_type(2)));
template <class Epi, class Sched, bool ALIGN_EPI = false, bool SP2 = false>
__device__ __forceinline__ void gemm_phase(PG8_LAS unsigned char* lds, const Gemm g, const Sched& S, const Epi& E, const int tid_in) {
    const int tid = tid_in, wid = __builtin_amdgcn_readfirstlane(tid >> 6), lane = tid & 63, wr = wid >> 2, wc = wid & 3, fr = lane & 15, fq = lane >> 4;
    const int K = g.K, nt = K / BK;
    unsigned voffA[2], voffB[2];
#pragma unroll
    for (int i = 0; i < 2; ++i) { int R, C; stage_rc(tid * 16 + i * 8192, R, C); const int Rb = Epi::PERM ? ((R & ~31) + perm32(R & 31)) : R;
        voffA[i] = (unsigned)(R * K + C) * 2u; voffB[i] = (unsigned)(Rb * K + C) * 2u; }
    const size_t kstep = (size_t)(BK * 2);
    const size_t hstep = (size_t)HALF * K * 2;
    const size_t tstep = 2 * hstep;
    const unsigned ldsw = (unsigned)wid * 1024u;
    const int aoff = lds_byte(wr * 64 + fr, fq * 8), boff = lds_byte(wc * 32 + fr, fq * 8);
#define PG8_SA(b, h) (((b) * 2 + (h)) * HTB)
#define PG8_SB(b, h) ((4 + (b) * 2 + (h)) * HTB)
#define PG8_STAGE(bufoff, gbase, voff) do { _Pragma("unroll") for (int _i = 0; _i < 2; ++_i) \
        __builtin_amdgcn_global_load_lds((const unsigned*)((const char*)(gbase) + (voff)[_i]), (PG8_LAS unsigned*)(lds + (bufoff) + ldsw + _i * 8192), 16, 0, 0); } while (0)
#define PG8_LDA(dst, b, h) do { _Pragma("unroll") for (int m = 0; m < 4; ++m) _Pragma("unroll") for (int k = 0; k < 2; ++k) dst[m][k] = *(const PG8_LAS bf16x8*)(lds + PG8_SA(b, h) + aoff + m * 2048 + k * 1024); } while (0)
#define PG8_LDB(dst, b, h) do { _Pragma("unroll") for (int n = 0; n < 2; ++n) _Pragma("unroll") for (int k = 0; k < 2; ++k) dst[n][k] = *(const PG8_LAS bf16x8*)(lds + PG8_SB(b, h) + boff + n * 2048 + k * 1024); } while (0)
#define PG8_MMA(ai, bj, At, Bt) do { __builtin_amdgcn_s_setprio(1); _Pragma("unroll") for (int m = 0; m < 4; ++m) _Pragma("unroll") for (int n = 0; n < 2; ++n) _Pragma("unroll") for (int k = 0; k < 2; ++k) \
        acc[ai][bj][m][n] = __builtin_amdgcn_mfma_f32_16x16x32_bf16(Bt[n][k], At[m][k], acc[ai][bj][m][n], 0, 0, 0); __builtin_amdgcn_s_setprio(0); } while (0)
#define PG8_WAIT_V(n) asm volatile("s_waitcnt vmcnt(" #n ")" ::: "memory")
#define PG8_WAIT_L(n) asm volatile("s_waitcnt lgkmcnt(" #n ")" ::: "memory")
#define PG8_BAR __builtin_amdgcn_s_barrier()
#define PG8_SCHED __builtin_amdgcn_sched_barrier(0)
    Unit cur, nxt; int ui = 0;
    if (!S.next(0, cur)) return;
    f32x4 acc[2][2][4][2];
#pragma unroll
    for (int a = 0; a < 2; ++a)
#pragma unroll
        for (int b = 0; b < 2; ++b)
#pragma unroll
            for (int m = 0; m < 4; ++m)
#pragma unroll
                for (int n = 0; n < 2; ++n) acc[a][b][m][n] = (f32x4){0.f, 0.f, 0.f, 0.f};
    bf16x8 At[4][2], B0[2][2], B1[2][2];
    const char* cA = (const char*)g.A + (size_t)cur.pm * tstep; const char* cB = (const char*)g.Bt + (size_t)cur.pn * tstep + (size_t)(cur.pm >> 5) * g.bstride;
    S.a_ready(cur);
    if constexpr (SP2) {
        PG8_STAGE(PG8_SB(0, 0), cB, voffB); PG8_STAGE(PG8_SB(0, 1), cB + hstep, voffB); PG8_STAGE(PG8_SA(0, 0), cA, voffA); PG8_STAGE(PG8_SA(0, 1), cA + hstep, voffA);
        if (wr == 1) PG8_BAR;
        PG8_WAIT_V(2); PG8_BAR;
        PG8_STAGE(PG8_SB(1, 0), cB + kstep, voffB); PG8_STAGE(PG8_SA(1, 0), cA + kstep, voffA); PG8_STAGE(PG8_SB(1, 1), cB + hstep + kstep, voffB);
        PG8_WAIT_V(6); PG8_BAR;
    } else {
        PG8_STAGE(PG8_SB(0, 0), cB, voffB); PG8_STAGE(PG8_SA(0, 0), cA, voffA); PG8_STAGE(PG8_SB(0, 1), cB + hstep, voffB); PG8_STAGE(PG8_SA(0, 1), cA + hstep, voffA);
        if (wr == 1) PG8_BAR;
        PG8_WAIT_V(4); PG8_BAR;
        PG8_STAGE(PG8_SB(1, 0), cB + kstep, voffB); PG8_STAGE(PG8_SA(1, 0), cA + kstep, voffA); PG8_STAGE(PG8_SB(1, 1), cB + hstep + kstep, voffB);
        PG8_WAIT_V(6); PG8_BAR;
    }
    for (;;) {
        const bool has_next = S.next(ui + 1, nxt);
        const char* nA = has_next ? (const char*)g.A + (size_t)nxt.pm * tstep : cA; const char* nB = has_next ? (const char*)g.Bt + (size_t)nxt.pn * tstep + (size_t)(nxt.pm >> 5) * g.bstride : cB;
        for (int t = 0; t < nt; t += 2) {
            const bool last = (t == nt - 2);
            const char* a1 = cA + (size_t)(t + 1) * kstep;
            const char* a2 = last ? nA : cA + (size_t)(t + 2) * kstep; const char* b2 = last ? nB : cB + (size_t)(t + 2) * kstep;
            const char* a3 = a2 + kstep; const char* b3 = b2 + kstep;
            if (last && has_next) S.a_ready(nxt);
            if constexpr (SP2) {
            PG8_LDB(B0, 0, 0); PG8_LDB(B1, 0, 1); PG8_SCHED; PG8_LDA(At, 0, 0); PG8_STAGE(PG8_SA(1, 1), a1 + hstep, voffA);
            PG8_WAIT_V(8); PG8_WAIT_L(0); PG8_BAR; PG8_MMA(0, 0, At, B0); PG8_MMA(0, 1, At, B1); PG8_BAR; PG8_SCHED;
            PG8_LDA(At, 0, 1); PG8_STAGE(PG8_SB(0, 0), b2, voffB); PG8_STAGE(PG8_SB(0, 1), b2 + hstep, voffB); PG8_STAGE(PG8_SA(0, 0), a2, voffA);
            PG8_WAIT_V(8); PG8_WAIT_L(0); PG8_BAR; PG8_MMA(1, 0, At, B0); PG8_MMA(1, 1, At, B1); PG8_BAR; PG8_SCHED;
            PG8_LDB(B0, 1, 0); PG8_LDB(B1, 1, 1); PG8_SCHED; PG8_LDA(At, 1, 0); PG8_STAGE(PG8_SA(0, 1), a2 + hstep, voffA);
            PG8_WAIT_V(8); PG8_WAIT_L(0); PG8_BAR; PG8_MMA(0, 0, At, B0); PG8_MMA(0, 1, At, B1); PG8_BAR; PG8_SCHED;
            PG8_LDA(At, 1, 1); PG8_STAGE(PG8_SB(1, 0), b3, voffB); PG8_STAGE(PG8_SB(1, 1), b3 + hstep, voffB); PG8_STAGE(PG8_SA(1, 0), a3, voffA);
            PG8_WAIT_V(8); PG8_WAIT_L(0); PG8_BAR; PG8_MMA(1, 0, At, B0); PG8_MMA(1, 1, At, B1); PG8_BAR; PG8_SCHED;
            } else {
            PG8_LDB(B0, 0, 0); PG8_SCHED; PG8_LDA(At, 0, 0); PG8_STAGE(PG8_SA(1, 1), a1 + hstep, voffA);
            PG8_WAIT_L(8); PG8_BAR; PG8_WAIT_L(0); PG8_MMA(0, 0, At, B0); PG8_BAR; PG8_SCHED;
            PG8_LDB(B1, 0, 1); PG8_STAGE(PG8_SB(0, 0), b2, voffB);
            PG8_BAR; PG8_WAIT_L(0); PG8_MMA(0, 1, At, B1); PG8_BAR;
            PG8_LDA(At, 0, 1); PG8_STAGE(PG8_SA(0, 0), a2, voffA);
            PG8_BAR; PG8_WAIT_L(0); PG8_MMA(1, 0, At, B0); PG8_BAR; PG8_SCHED;
            PG8_STAGE(PG8_SB(0, 1), b2 + hstep, voffB);
            PG8_WAIT_V(6); PG8_BAR; PG8_MMA(1, 1, At, B1); PG8_BAR;
            PG8_LDB(B0, 1, 0); PG8_SCHED; PG8_LDA(At, 1, 0); PG8_STAGE(PG8_SA(0, 1), a2 + hstep, voffA);
            PG8_WAIT_L(8); PG8_BAR; PG8_WAIT_L(0); PG8_MMA(0, 0, At, B0); PG8_BAR; PG8_SCHED;
            PG8_LDB(B1, 1, 1); PG8_STAGE(PG8_SB(1, 0), b3, voffB);
            PG8_BAR; PG8_WAIT_L(0); PG8_MMA(0, 1, At, B1); PG8_BAR;
            PG8_LDA(At, 1, 1); PG8_STAGE(PG8_SA(1, 0), a3, voffA);
            PG8_BAR; PG8_WAIT_L(0); PG8_MMA(1, 0, At, B0); PG8_BAR; PG8_SCHED;
            PG8_STAGE(PG8_SB(1, 1), b3 + hstep, voffB);
            PG8_WAIT_V(6); PG8_BAR; PG8_MMA(1, 1, At, B1); PG8_BAR;
            }
        }
        if constexpr (ALIGN_EPI) { if (wr == 0) PG8_BAR; }
        if constexpr (!Epi::AFTER_DRAIN) { E(acc, cur, wr, wc, fr, fq); S.done(cur); }
        if (!has_next) break;
#pragma unroll
        for (int a = 0; a < 2; ++a)
#pragma unroll
            for (int b = 0; b < 2; ++b)
#pragma unroll
                for (int m = 0; m < 4; ++m)
#pragma unroll
                    for (int n = 0; n < 2; ++n) acc[a][b][m][n] = (f32x4){0.f, 0.f, 0.f, 0.f};
        cur = nxt; cA = nA; cB = nB; ++ui;
        if constexpr (ALIGN_EPI) { if (wr == 1) PG8_BAR; }
    }
    PG8_WAIT_V(0);
    if constexpr (!ALIGN_EPI) { if (wr == 0) PG8_BAR; }
    PG8_BAR;
    if constexpr (Epi::AFTER_DRAIN) { E.fused(acc, cur, wr, wc, fr, fq, lds, wid, lane); S.done(cur); }
#undef PG8_SA
#undef PG8_SB
#undef PG8_STAGE
#undef PG8_LDA
#undef PG8_LDB
#undef PG8_MMA
#undef PG8_WAIT_V
#undef PG8_WAIT_L
#undef PG8_BAR
#undef PG8_SCHED
}
}

#ifndef MK_MULTI
#define MK_MULTI 0
#endif
#define LAS __attribute__((address_space(3)))
typedef unsigned short bf16;
typedef unsigned v4u __attribute__((ext_vector_type(4)));
typedef unsigned v2u __attribute__((ext_vector_type(2)));
typedef float f32x4 __attribute__((ext_vector_type(4)));
typedef short bf16x8 __attribute__((ext_vector_type(8)));

constexpr int NB = 2, SEQ = 8192, MTOK = NB * SEQ, DM = 1024, FF = 2816, DIN = 3212, DINP = 3328, NGU = 2 * FF;
constexpr int MQ0 = 512, MK0 = 896, MV0 = 1280, GQ0 = 1664, GZ0 = 2816, GA0 = 3200, GB0 = 3206;
constexpr int NPH = 22;
constexpr float EPS = 1e-6f;
constexpr size_t MiB = 1u << 20;
constexpr size_t WS_RS = 0, WS_MOD = 458752, WS_BIAS = 606208, CTL_ZERO = 1 * MiB;
constexpr int BIAS_L = 2 * (NGU + DINP + NGU);
constexpr size_t WS_ROPE = 1 * MiB, WS_KMEAN = 1 * MiB + 512 * 1024, WS_KNMAX = WS_KMEAN + 98304, WS_EGL = WS_KMEAN + 102400;
constexpr size_t WS_W = 2 * MiB;
constexpr size_t W_1GU = 0, W_D1 = 22 * MiB, W_IN = W_D1 + 5 * MiB + 512 * 1024, W_OUT = W_IN + 13 * MiB, W_2GU = W_OUT + 2 * MiB, W_D2 = W_2GU + 22 * MiB;
constexpr size_t WS_XB = 72 * MiB, WS_AQD = 72 * MiB, WS_AKD = 84 * MiB;
constexpr size_t WS_U = 104 * MiB, WS_Y = 208 * MiB, WS_AW = 240 * MiB, WS_AQK = 252 * MiB, WS_UD = 264 * MiB, WS_VT = 276 * MiB, WS_SV = 288 * MiB, WS_END = 300 * MiB;
constexpr size_t WS_KT = WS_W + W_IN;
static_assert(W_D2 + 5 * MiB + 512 * 1024 == 70 * MiB, "weights");
constexpr int LDS_BYTES = 163840;
constexpr size_t WS_BAR = 851968;
constexpr int LDS_BARST = 163776;

struct Params { const float* in[24]; float* out; unsigned char* ws; int ph_lo, ph_hi; };

__device__ __forceinline__ float bf2f(bf16 v) { return __uint_as_float(((unsigned)v) << 16); }
typedef float f32x2_t __attribute__((ext_vector_type(2)));
typedef __bf16 bf16x2_t __attribute__((ext_vector_type(2)));
__device__ __forceinline__ unsigned pk2(float lo, float hi) { const f32x2_t v = {lo, hi}; const bf16x2_t b = __builtin_convertvector(v, bf16x2_t); return __builtin_bit_cast(unsigned, b); }
__device__ __forceinline__ float sigmoid_f(float x) { return __builtin_amdgcn_rcpf(1.f + __expf(-x)); }
__device__ __forceinline__ float silu_f(float x) { return x * sigmoid_f(x); }
__device__ __forceinline__ float wave_sum(float v) {
#pragma unroll
    for (int o = 1; o < 64; o <<= 1) v += __shfl_xor(v, o);
    return v;
}
__device__ __forceinline__ void gadd(float* p, float v) { __hip_atomic_fetch_add(p, v, __ATOMIC_RELAXED, __HIP_MEMORY_SCOPE_AGENT); }
__device__ __forceinline__ void ladd(LAS float* p, float v) { __hip_atomic_fetch_add(p, v, __ATOMIC_RELAXED, __HIP_MEMORY_SCOPE_WORKGROUP); }
__device__ __forceinline__ bf16x8 pack8(f32x4 a, f32x4 b) {
    v4u w; w.x = pk2(a[0], a[1]); w.y = pk2(a[2], a[3]); w.z = pk2(b[0], b[1]); w.w = pk2(b[2], b[3]);
    return __builtin_bit_cast(bf16x8, w);
}
#define MFMA16(a, b, c) __builtin_amdgcn_mfma_f32_16x16x32_bf16((a), (b), (c), 0, 0, 0)

#define XB_TMO      128
#define XB_XCNT(j)  (256  + 64 * (j))
#define XB_XSUB(j)  (1280 + 64 * (j))
#define XB_XGEN(j)  (2304 + 64 * (j))
#define XB_TOP      3328
#define XB_TOPGEN   3392
#define XCD_BAR_WORDS 3456
#define XB_SPIN_CAP (1u << 18)

__device__ __forceinline__ unsigned xb_ld(unsigned* p)              { return __hip_atomic_load(p, __ATOMIC_RELAXED, __HIP_MEMORY_SCOPE_AGENT); }
__device__ __forceinline__ unsigned xb_add(unsigned* p, unsigned v) { return __hip_atomic_fetch_add(p, v, __ATOMIC_RELAXED, __HIP_MEMORY_SCOPE_AGENT); }
__device__ __forceinline__ unsigned xb_xcc_id() { return (unsigned)__builtin_amdgcn_s_getreg((3 << 11) | 20) & 0xFu; }
#define XB_SPIN(cond, bar) do { unsigned _sp = 0; while (cond) { __builtin_amdgcn_s_sleep(1); \
    if ((++_sp & 255u) == 0u) { if (xb_ld(&(bar)[XB_TMO])) break; if (_sp > XB_SPIN_CAP) { atomicAdd(&(bar)[XB_TMO], 1u); break; } } } } while (0)

struct XcdBarrier {
    unsigned* bar; unsigned x;
    volatile LAS unsigned* st;
};

__device__ __forceinline__ XcdBarrier xcd_barrier_post(unsigned* bar, volatile LAS unsigned* st) {
    XcdBarrier b; b.bar = bar; b.x = xb_xcc_id(); b.st = st;
    if (threadIdx.x == 0) (void)xb_add(&bar[XB_XCNT(b.x)], 1u);
    return b;
}
__device__ __forceinline__ void xcd_barrier_complete(unsigned* bar, unsigned x, unsigned& nloc, unsigned& nx) {
    const unsigned G = gridDim.x * gridDim.y * gridDim.z;
    unsigned sum, cnt, mine, sp = 0u;
    for (;;) {
        sum = 0u; cnt = 0u; mine = 0u;
#pragma unroll
        for (unsigned j = 0; j < 16; ++j) { const unsigned c = xb_ld(&bar[XB_XCNT(j)]); sum += c; cnt += (c > 0u) ? 1u : 0u; mine = (j == x) ? c : mine; }
        if (sum == G) break;
        __builtin_amdgcn_s_sleep(1);
        if ((++sp & 255u) == 0u) { if (xb_ld(&bar[XB_TMO])) break; if (sp > XB_SPIN_CAP) { atomicAdd(&bar[XB_TMO], 1u); break; } }
    }
    nloc = mine > 0u ? mine : 1u; nx = cnt > 0u ? cnt : 1u;
}

__device__ __forceinline__ void xcd_barrier(const XcdBarrier& b) {
    asm volatile("s_waitcnt vmcnt(0)" ::: "memory");
    __syncthreads();
    if (threadIdx.x == 0) {
        unsigned* bar = b.bar;
        __builtin_amdgcn_s_waitcnt(0);
        unsigned nloc = b.st[0], nx = b.st[1];
        if (nloc == 0u) { xcd_barrier_complete(bar, b.x, nloc, nx); b.st[0] = nloc; b.st[1] = nx; }
        const unsigned old = xb_add(&bar[XB_XSUB(b.x)], 1u);
        const unsigned gen = old / nloc;
        if (old + 1u == (gen + 1u) * nloc) {
            __builtin_amdgcn_fence(__ATOMIC_RELEASE, "agent");
            asm volatile("s_waitcnt vmcnt(0)" ::: "memory");
            const unsigned og = xb_add(&bar[XB_TOP], 1u);
            const unsigned tg = og / nx;
            if (og + 1u == (tg + 1u) * nx) xb_add(&bar[XB_TOPGEN], 1u);
            else XB_SPIN(xb_ld(&bar[XB_TOPGEN]) == tg, bar);
            __builtin_amdgcn_fence(__ATOMIC_ACQUIRE, "agent");
            xb_add(&bar[XB_XGEN(b.x)], 1u);
            asm volatile("s_waitcnt vmcnt(0)" ::: "memory");
        } else {
            XB_SPIN(xb_ld(&bar[XB_XGEN(b.x)]) == gen, bar);
            __builtin_amdgcn_fence(__ATOMIC_ACQUIRE, "agent");
            asm volatile("s_waitcnt vmcnt(0)" ::: "memory");
        }
    }
    __syncthreads();
}

struct EpiGU {
    static constexpr bool PERM = true, AFTER_DRAIN = false;
    bf16* act; const float* rs; const float* bias;
    __device__ __forceinline__ void operator()(const f32x4 (&acc)[2][2][4][2], const pg8::Unit& u, int wr, int wc, int fr, int fq) const {
        const int b = u.pm >> 5;
        const float* bb = bias + b * NGU + u.pn * 256 + wc * 32 + 8 * fq;
        const f32x4 bg0 = *(const f32x4*)(bb), bg1 = *(const f32x4*)(bb + 4), bu0 = *(const f32x4*)(bb + 128), bu1 = *(const f32x4*)(bb + 132);
        float rsall[2][4];
#pragma unroll
        for (int ai = 0; ai < 2; ++ai)
#pragma unroll
            for (int m = 0; m < 4; ++m) rsall[ai][m] = rs[u.pm * 256 + ai * 128 + wr * 64 + m * 16 + fr];
#pragma unroll
        for (int ai = 0; ai < 2; ++ai)
#pragma unroll
            for (int m = 0; m < 4; ++m) {
                const int row = u.pm * 256 + ai * 128 + wr * 64 + m * 16 + fr;
                const float rstd = rsqrtf(rsall[ai][m] * (1.f / DM) + EPS);
                const f32x4 g0 = acc[ai][0][m][0] * rstd + bg0, g1 = acc[ai][0][m][1] * rstd + bg1;
                const f32x4 u0 = acc[ai][1][m][0] * rstd + bu0, u1 = acc[ai][1][m][1] * rstd + bu1;
                v4u w;
                w.x = pk2(silu_f(g0[0]) * u0[0], silu_f(g0[1]) * u0[1]); w.y = pk2(silu_f(g0[2]) * u0[2], silu_f(g0[3]) * u0[3]);
                w.z = pk2(silu_f(g1[0]) * u1[0], silu_f(g1[1]) * u1[1]); w.w = pk2(silu_f(g1[2]) * u1[2], silu_f(g1[3]) * u1[3]);
                *(v4u*)(act + (size_t)row * FF + u.pn * 128 + wc * 32 + 8 * fq) = w;
            }
    }
};
struct EpiRes {
    static constexpr bool PERM = true, AFTER_DRAIN = false;
    const float* xin; float* x; bf16* xb; float* rsn; const float* gate; float gmul;
    __device__ __forceinline__ void operator()(const f32x4 (&acc)[2][2][4][2], const pg8::Unit& u, int wr, int wc, int fr, int fq) const {
        const int b = u.pm >> 5, col0 = u.pn * 256 + wc * 32 + 8 * fq;
        f32x4 (&ac)[2][2][4][2] = const_cast<f32x4 (&)[2][2][4][2]>(acc);
        {   f32x4 gt[2][2];
#pragma unroll
            for (int bj = 0; bj < 2; ++bj)
#pragma unroll
                for (int n = 0; n < 2; ++n) gt[bj][n] = *(const f32x4*)(gate + b * 9216 + col0 + 128 * bj + 4 * n) * gmul;
#pragma unroll
            for (int ai = 0; ai < 2; ++ai)
#pragma unroll
                for (int bj = 0; bj < 2; ++bj)
#pragma unroll
                    for (int m = 0; m < 4; ++m) { ac[ai][bj][m][0] *= gt[bj][0]; ac[ai][bj][m][1] *= gt[bj][1]; } }
#pragma unroll
        for (int bt = 0; bt < 3; ++bt) {
            const int g0 = 3 * bt, ng = bt < 2 ? 3 : 2;
            f32x4 xv[3][2][2];
#pragma unroll
            for (int gi = 0; gi < 3; ++gi) if (gi < ng) { const int ai = (g0 + gi) >> 2, m = (g0 + gi) & 3;
#pragma unroll
                for (int bj = 0; bj < 2; ++bj) { const float* pi = xin + (size_t)(u.pm * 256 + ai * 128 + wr * 64 + m * 16 + fr) * DM + col0 + 128 * bj; xv[gi][bj][0] = *(const f32x4*)pi; xv[gi][bj][1] = *(const f32x4*)(pi + 4); } }
#pragma unroll
            for (int gi = 0; gi < 3; ++gi) if (gi < ng) {
                const int ai = (g0 + gi) >> 2, m = (g0 + gi) & 3, row = u.pm * 256 + ai * 128 + wr * 64 + m * 16 + fr;
                float ss = 0.f;
#pragma unroll
                for (int bj = 0; bj < 2; ++bj) {
                    float* px = x + (size_t)row * DM + col0 + 128 * bj;
                    f32x4 x0 = xv[gi][bj][0] + ac[ai][bj][m][0], x1 = xv[gi][bj][1] + ac[ai][bj][m][1];
                    *(f32x4*)px = x0; *(f32x4*)(px + 4) = x1;
                    ss += (x0[0] * x0[0] + x0[1] * x0[1]) + (x0[2] * x0[2] + x0[3] * x0[3]) + (x1[0] * x1[0] + x1[1] * x1[1]) + (x1[2] * x1[2] + x1[3] * x1[3]);
                    v4u w; w.x = pk2(x0[0], x0[1]); w.y = pk2(x0[2], x0[3]); w.z = pk2(x1[0], x1[1]); w.w = pk2(x1[2], x1[3]);
                    *(v4u*)(xb + (size_t)row * DM + col0 + 128 * bj) = w;
                }
                ss += __shfl_xor(ss, 16); ss += __shfl_xor(ss, 32);
                if (fq == 0) gadd(rsn + row, ss);
            }
            asm volatile("" ::: "memory");
        }
    }
};
struct EpiIn {
    static constexpr bool PERM = true, AFTER_DRAIN = false;
    bf16* U; const float* rs; const float* bias; const float* rope;
    __device__ __forceinline__ void operator()(const f32x4 (&acc)[2][2][4][2], const pg8::Unit& u, int wr, int wc, int fr, int fq) const {
        const int b = u.pm >> 5, col0 = u.pn * 256 + wc * 32 + 8 * fq;
        const bool ropetile = (u.pn >= 2 && u.pn <= 4);
        const bool ropelane = ropetile && !(wc & 1) && fq < 2;
        const float* bp = bias + b * DINP + col0;
        f32x4 bv[2][2];
#pragma unroll
        for (int bj = 0; bj < 2; ++bj) { bv[bj][0] = *(const f32x4*)(bp + 128 * bj); bv[bj][1] = *(const f32x4*)(bp + 128 * bj + 4); }
        const float sg = fq == 0 ? -1.f : 1.f;
        float rsall[2][4];
#pragma unroll
        for (int ai = 0; ai < 2; ++ai)
#pragma unroll
            for (int m = 0; m < 4; ++m) rsall[ai][m] = rs[u.pm * 256 + ai * 128 + wr * 64 + m * 16 + fr];
#pragma unroll
        for (int am = 0; am < 4; ++am) {
            const int ai = am >> 1, m0 = (am & 1) * 2;
            f32x4 cs[2][4];
            if (ropelane) {
#pragma unroll
                for (int mm = 0; mm < 2; ++mm) { const float* rp = rope + (size_t)((u.pm * 256 + ai * 128 + wr * 64 + (m0 + mm) * 16 + fr) & (SEQ - 1)) * 16;
                    cs[mm][0] = *(const f32x4*)rp; cs[mm][1] = *(const f32x4*)(rp + 4); cs[mm][2] = *(const f32x4*)(rp + 8) * sg; cs[mm][3] = *(const f32x4*)(rp + 12) * sg; } }
#pragma unroll
            for (int mm = 0; mm < 2; ++mm) {
                const int m = m0 + mm, row = u.pm * 256 + ai * 128 + wr * 64 + m * 16 + fr;
                const float rst = rsqrtf(rsall[ai][m] * (1.f / DM) + EPS);
#pragma unroll
                for (int bj = 0; bj < 2; ++bj) {
                    f32x4 v0 = acc[ai][bj][m][0] * rst + bv[bj][0], v1 = acc[ai][bj][m][1] * rst + bv[bj][1];
                    if (ropetile) {
                        f32x4 p0, p1;
#pragma unroll
                        for (int j = 0; j < 4; ++j) { p0[j] = __shfl_xor(v0[j], 16); p1[j] = __shfl_xor(v1[j], 16); }
                        if (ropelane) { v0 = v0 * cs[mm][0] + p0 * cs[mm][2]; v1 = v1 * cs[mm][1] + p1 * cs[mm][3]; }
                    }
                    v4u w; w.x = pk2(v0[0], v0[1]); w.y = pk2(v0[2], v0[3]); w.z = pk2(v1[0], v1[1]); w.w = pk2(v1[2], v1[3]);
                    *(v4u*)(U + (size_t)row * DINP + col0 + 128 * bj) = w;
                }
            }
            asm volatile("" ::: "memory");
        }
    }
};

__device__ __forceinline__ void phase_pre(const Params& p, int tid, int wave, int lane) {
    const int gw = blockIdx.x * 8 + wave, NGW = gridDim.x * 8;
    const float* x = p.in[0]; bf16* xb = (bf16*)(p.ws + WS_XB); float* rs = (float*)(p.ws + WS_RS);
    for (int row0 = gw; row0 < MTOK; row0 += 4 * NGW) {
        f32x4 v[4][4];
#pragma unroll
        for (int rr = 0; rr < 4; ++rr) { const int row = row0 + rr * NGW; const f32x4* xr = (const f32x4*)(x + (size_t)(row < MTOK ? row : row0) * DM) + lane;
#pragma unroll
            for (int j = 0; j < 4; ++j) v[rr][j] = xr[64 * j]; }
#pragma unroll
        for (int rr = 0; rr < 4; ++rr) { const int row = row0 + rr * NGW; if (row < MTOK) {
            v2u* xbr = (v2u*)(xb + (size_t)row * DM) + lane; float ss = 0.f;
#pragma unroll
            for (int j = 0; j < 4; ++j) { const f32x4 t = v[rr][j]; ss += (t[0] * t[0] + t[1] * t[1]) + (t[2] * t[2] + t[3] * t[3]);
                v2u w; w.x = pk2(t[0], t[1]); w.y = pk2(t[2], t[3]); xbr[64 * j] = w; }
            ss = wave_sum(ss); if (lane == 0) rs[row] = ss; } }
    }
    const float* cvec = p.in[1]; const float* w_ada = p.in[2]; const float* b_ada = p.in[3]; float* mod = (float*)(p.ws + WS_MOD);
    for (int it = gw; it < 2304; it += NGW) {
        const int l = it / 1152, r = it % 1152, nc = r >> 5, kr = r & 31;
        const float* W = w_ada + ((size_t)l * 1024 + kr * 32) * 9216 + nc * 256 + lane * 4;
        f32x4 a0 = {0.f, 0.f, 0.f, 0.f}, a1 = a0;
        const unsigned csv = __float_as_uint(silu_f(cvec[(lane >> 5) * 1024 + kr * 32 + (lane & 31)]));
#pragma unroll
        for (int k = 0; k < 32; ++k) { const f32x4 w = *(const f32x4*)(W + (size_t)k * 9216); const float c0 = __uint_as_float((unsigned)__builtin_amdgcn_readlane((int)csv, k)), c1 = __uint_as_float((unsigned)__builtin_amdgcn_readlane((int)csv, 32 + k)); a0 += w * c0; a1 += w * c1; }
        if (kr == 0) { const f32x4 bb = *(const f32x4*)(b_ada + l * 9216 + nc * 256 + lane * 4); a0 += bb; a1 += bb; }
        float* m0 = mod + (l * 2 + 0) * 9216 + nc * 256 + lane * 4; float* m1 = m0 + 9216;
#pragma unroll
        for (int j = 0; j < 4; ++j) { gadd(m0 + j, a0[j]); gadd(m1 + j, a1[j]); }
    }
    float* rope = (float*)(p.ws + WS_ROPE);
    for (int idx = blockIdx.x * 512 + tid; idx < SEQ * 8; idx += gridDim.x * 512) {
        const int pos = idx >> 3, i = idx & 7; const float inv = expf(-logf(500000.0f) * (float)(2 * i) / 16.0f); const float ang = (float)pos * inv;
        float s, c; sincosf(ang, &s, &c); rope[pos * 16 + i] = c; rope[pos * 16 + 8 + i] = s;
    }
}

__device__ __forceinline__ int rowmap(int n, int mode) { return mode == 0 ? n : (((n >> 7) << 8) + (n & 127) + (mode == 2 ? 128 : 0)); }
__device__ __forceinline__ void cvt_tile(const float* W, int K, int N, bf16* WT0, bf16* WT1, int mode, const float* g, const float* sc0, const float* sc1, const float* sh0, const float* sh1,
                                         float* bias0, float* bias1, int kb, int nb, LAS float* scr, int lane) {
    const int k0 = 64 * kb, n0 = 64 * nb, n = n0 + lane; const bool valid = n < N;
    {   const int r4 = lane >> 4, c4 = lane & 15; const bool v4ok = (n0 + 4 * c4) < N;
        f32x4 wv[16];
#pragma unroll
        for (int i = 0; i < 16; ++i) wv[i] = v4ok ? *(const f32x4*)(W + (size_t)(k0 + 4 * i + r4) * N + n0 + 4 * c4) : (f32x4){0.f, 0.f, 0.f, 0.f};
#pragma unroll
        for (int i = 0; i < 16; ++i) { LAS float* d = scr + (4 * i + r4) * 65 + 4 * c4; d[0] = wv[i][0]; d[1] = wv[i][1]; d[2] = wv[i][2]; d[3] = wv[i][3]; } }
    if (g) {
        float s0 = 0.f, s1 = 0.f;
        const unsigned sh0v = __float_as_uint(sh0[k0 + lane]), sh1v = __float_as_uint(sh1[k0 + lane]);
#pragma unroll
        for (int i = 0; i < 64; ++i) { const float w = scr[i * 65 + lane];
            s0 += w * __uint_as_float((unsigned)__builtin_amdgcn_readlane((int)sh0v, i)); s1 += w * __uint_as_float((unsigned)__builtin_amdgcn_readlane((int)sh1v, i)); }
        if (valid) { gadd(bias0 + rowmap(n, mode), s0); gadd(bias1 + rowmap(n, mode), s1); }
    }
    const int c = lane & 7;
    float k0s[8], k1s[8];
#pragma unroll
    for (int t = 0; t < 8; ++t) { if (g) { const float gk = g[k0 + 8 * c + t]; k0s[t] = gk * (1.f + sc0[k0 + 8 * c + t]); k1s[t] = gk * (1.f + sc1[k0 + 8 * c + t]); } else { k0s[t] = 1.f; k1s[t] = 1.f; } }
#pragma unroll
    for (int j = 0; j < 8; ++j) {
        const int nn = (lane >> 3) + 8 * j; const size_t row = (size_t)rowmap(n0 + nn, mode);
        float v[8];
#pragma unroll
        for (int t = 0; t < 8; ++t) v[t] = scr[(8 * c + t) * 65 + nn];
        v4u o; o.x = pk2(v[0] * k0s[0], v[1] * k0s[1]); o.y = pk2(v[2] * k0s[2], v[3] * k0s[3]); o.z = pk2(v[4] * k0s[4], v[5] * k0s[5]); o.w = pk2(v[6] * k0s[6], v[7] * k0s[7]);
        *(v4u*)(WT0 + row * K + k0 + 8 * c) = o;
        if (WT1) { v4u q; q.x = pk2(v[0] * k1s[0], v[1] * k1s[1]); q.y = pk2(v[2] * k1s[2], v[3] * k1s[3]); q.z = pk2(v[4] * k1s[4], v[5] * k1s[5]); q.w = pk2(v[6] * k1s[6], v[7] * k1s[7]);
            *(v4u*)(WT1 + row * K + k0 + 8 * c) = q; }
    }
}
__device__ __forceinline__ void phase_cvt(const Params& p, int l, LAS unsigned char* lds, int wave, int lane, int lo, int hi, int gw, int NGW) {
    LAS float* scr = (LAS float*)(lds + wave * 16640);
    unsigned char* wb = p.ws + WS_W; const float* mod0 = (const float*)(p.ws + WS_MOD) + (l * 2) * 9216; const float* mod1 = mod0 + 9216;
    float* bias = (float*)(p.ws + WS_BIAS) + l * BIAS_L;
    for (int it = lo + gw; it < hi; it += NGW) {
        int r = it;
        if (r < 1408) { const int up = r >= 704; r -= up * 704; const float* W = p.in[up ? 6 : 5] + (size_t)l * DM * FF;
            cvt_tile(W, DM, FF, (bf16*)(wb + W_1GU), (bf16*)(wb + W_1GU) + (size_t)NGU * DM, 1 + up, p.in[4] + l * DM, mod0 + 1024, mod1 + 1024, mod0, mod1, bias, bias + NGU, r / 44, r % 44, scr, lane); continue; }
        r -= 1408;
        if (r < 704) { cvt_tile(p.in[7] + (size_t)l * FF * DM, FF, DM, (bf16*)(wb + W_D1), nullptr, 0, nullptr, nullptr, nullptr, nullptr, nullptr, nullptr, nullptr, r / 16, r % 16, scr, lane); continue; }
        r -= 704;
        if (r < 832) { cvt_tile(p.in[9] + (size_t)l * DM * DIN, DM, DIN, (bf16*)(wb + W_IN), (bf16*)(wb + W_IN) + (size_t)DINP * DM, 0, p.in[8] + l * DM, mod0 + 4096, mod1 + 4096, mod0 + 3072, mod1 + 3072,
                                bias + 2 * NGU, bias + 2 * NGU + DINP, r / 52, r % 52, scr, lane); continue; }
        r -= 832;
        if (r < 256) { cvt_tile(p.in[18] + (size_t)l * DM * DM, DM, DM, (bf16*)(wb + W_OUT), nullptr, 0, nullptr, nullptr, nullptr, nullptr, nullptr, nullptr, nullptr, r / 16, r % 16, scr, lane); continue; }
        r -= 256;
        if (r < 1408) { const int up = r >= 704; r -= up * 704; const float* W = p.in[up ? 21 : 20] + (size_t)l * DM * FF;
            cvt_tile(W, DM, FF, (bf16*)(wb + W_2GU), (bf16*)(wb + W_2GU) + (size_t)NGU * DM, 1 + up, p.in[19] + l * DM, mod0 + 7168, mod1 + 7168, mod0 + 6144, mod1 + 6144,
                     bias + 2 * NGU + 2 * DINP, bias + 2 * NGU + 2 * DINP + NGU, r / 44, r % 44, scr, lane); continue; }
        r -= 1408;
        cvt_tile(p.in[22] + (size_t)l * FF * DM, FF, DM, (bf16*)(wb + W_D2), nullptr, 0, nullptr, nullptr, nullptr, nullptr, nullptr, nullptr, nullptr, r / 16, r % 16, scr, lane);
    }
}

__device__ __forceinline__ void conv_item(const Params& p, int l, int item, LAS float* hs, int tid, int wave, int lane) {
    const bf16* U = (const bf16*)(p.ws + WS_U); bf16* Y = (bf16*)(p.ws + WS_Y);
    const int t0 = item * 64, b = t0 >> 13, tp0 = t0 & (SEQ - 1);
    const int c = tid & 255, hf = tid >> 8;
    float w[31], acc[32];
#pragma unroll
    for (int k = 0; k < 31; ++k) w[k] = p.in[10][(l * 31 + k) * 256 + c];
    const float bias = p.in[11][l * 256 + c];
    {   v4u av[6], gv[6];
#pragma unroll
        for (int i = 0; i < 6; ++i) { const int ti = tid + 512 * i, r = ti >> 5, c8 = ti & 31, tp = tp0 - 30 + r; av[i] = (v4u){0u, 0u, 0u, 0u}; gv[i] = av[i];
            if (ti < 3008 && tp >= 0) { const bf16* ur = U + (size_t)(b * SEQ + tp) * DINP + 8 * c8; av[i] = *(const v4u*)ur; gv[i] = *(const v4u*)(ur + 256); } }
#pragma unroll
        for (int i = 0; i < 6; ++i) { const int ti = tid + 512 * i, r = ti >> 5, c8 = ti & 31;
            if (ti < 3008) { const unsigned aw[4] = {av[i].x, av[i].y, av[i].z, av[i].w}, gw[4] = {gv[i].x, gv[i].y, gv[i].z, gv[i].w};
                float hv8[8];
#pragma unroll
                for (int j = 0; j < 4; ++j) { hv8[2 * j] = __uint_as_float(aw[j] << 16) * sigmoid_f(__uint_as_float(gw[j] << 16));
                    hv8[2 * j + 1] = __uint_as_float(aw[j] & 0xffff0000u) * sigmoid_f(__uint_as_float(gw[j] & 0xffff0000u)); }
                *(LAS f32x4*)(hs + r * 256 + 8 * c8) = (f32x4){hv8[0], hv8[1], hv8[2], hv8[3]}; *(LAS f32x4*)(hs + r * 256 + 8 * c8 + 4) = (f32x4){hv8[4], hv8[5], hv8[6], hv8[7]}; } }
    }
    __syncthreads();
#pragma unroll
    for (int r = 0; r < 32; ++r) acc[r] = bias;
#pragma unroll
    for (int j = 0; j < 62; ++j) { const float hv = hs[(32 * hf + j) * 256 + c];
#pragma unroll
        for (int r = 0; r < 32; ++r) { const int k = j - r; if (k >= 0 && k < 31) acc[r] += hv * w[k]; } }
    __syncthreads();
#pragma unroll
    for (int r = 0; r < 32; ++r) hs[(32 * hf + r) * 256 + c] = acc[r];
    __syncthreads();
    const float* lg = p.in[12] + l * 256; const float* lb = p.in[13] + l * 256;
    const f32x4 lgv = *(const f32x4*)(lg + 4 * lane), lbv = *(const f32x4*)(lb + 4 * lane);
    for (int rr = 0; rr < 8; ++rr) { const int row = wave * 8 + rr;
        f32x4 v = *(const LAS f32x4*)(hs + row * 256 + 4 * lane);
        const float mu = wave_sum((v[0] + v[1]) + (v[2] + v[3])) * (1.f / 256.f);
        v -= mu;
        const float rstd = rsqrtf(wave_sum((v[0] * v[0] + v[1] * v[1]) + (v[2] * v[2] + v[3] * v[3])) * (1.f / 256.f) + EPS);
        const f32x4 yv = v * rstd * lgv + lbv;
        v2u w; w.x = pk2(silu_f(yv[0]), silu_f(yv[1])); w.y = pk2(silu_f(yv[2]), silu_f(yv[3]));
        *(v2u*)(Y + (size_t)(t0 + row) * DM + 4 * lane) = w; }
    __syncthreads();
}
__device__ __forceinline__ void mobaprep_item(const Params& p, int item, LAS unsigned char* lds, int tid) {
    const bf16* U = (const bf16*)(p.ws + WS_U);
    const int bh = item >> 5, j = item & 31, b = bh / 6, h = bh % 6; const size_t base = (size_t)b * SEQ + j * 256;
    LAS unsigned* vs = (LAS unsigned*)lds;
    LAS unsigned* ksl = (LAS unsigned*)(lds + 33792);
    LAS float* ksum = (LAS float*)(lds + 67584);
    LAS unsigned* kmx = (LAS unsigned*)(lds + 67584 + 2048);
    v4u kv[4], vv[4];
#pragma unroll
    for (int i = 0; i < 4; ++i) { const int idx = tid + 512 * i, row = idx >> 3, pc = idx & 7; const bf16* rp = U + (base + row) * DINP + h * 64 + 8 * pc; kv[i] = *(const v4u*)(rp + MK0); vv[i] = *(const v4u*)(rp + MV0); }
    if (tid == 0) kmx[0] = 0u;
    __syncthreads();
    float nmax = 0.f;
#pragma unroll
    for (int i = 0; i < 4; ++i) { const int idx = tid + 512 * i, row = idx >> 3, pc = idx & 7;
        LAS unsigned* dk = ksl + row * 33 + 4 * pc; dk[0] = kv[i].x; dk[1] = kv[i].y; dk[2] = kv[i].z; dk[3] = kv[i].w;
        LAS unsigned* dv = vs + row * 33 + 4 * pc; dv[0] = vv[i].x; dv[1] = vv[i].y; dv[2] = vv[i].z; dv[3] = vv[i].w;
        const unsigned w4[4] = {kv[i].x, kv[i].y, kv[i].z, kv[i].w}; float ss = 0.f;
#pragma unroll
        for (int t = 0; t < 4; ++t) { const float a0 = __uint_as_float(w4[t] << 16), a1 = __uint_as_float(w4[t] & 0xffff0000u); ss += a0 * a0 + a1 * a1; }
        ss += __shfl_xor(ss, 1); ss += __shfl_xor(ss, 2); ss += __shfl_xor(ss, 4);
        nmax = fmaxf(nmax, ss); }
#pragma unroll
    for (int o = 8; o < 64; o <<= 1) nmax = fmaxf(nmax, __shfl_xor(nmax, o));
    if ((tid & 63) == 0) __hip_atomic_fetch_max(kmx, __float_as_uint(sqrtf(nmax)), __ATOMIC_RELAXED, __HIP_MEMORY_SCOPE_WORKGROUP);
    __syncthreads();
    { const int d = tid & 63, part = tid >> 6; const LAS bf16* kb = (const LAS bf16*)ksl; float s = 0.f;
#pragma unroll 8
      for (int r = 0; r < 32; ++r) s += bf2f(kb[(part * 32 + r) * 66 + d]);
      ksum[part * 64 + d] = s; }
    {
        bf16* Kt = (bf16*)(p.ws + WS_KT) + ((size_t)bh * 256 + j * 8) * 2048; bf16* Vt = (bf16*)(p.ws + WS_VT) + ((size_t)bh * 256 + j * 8) * 2048;
        const LAS bf16* vsb = (const LAS bf16*)vs;
#pragma unroll
        for (int i = 0; i < 4; ++i) { const int q = tid + 512 * i, c8 = q >> 8, pidx = q & 255, m = pidx & 15, g = (pidx >> 4) & 3;
            { const int ks = (pidx >> 6) & 1, tt = pidx >> 7, key = 32 * c8 + 8 * (m >> 2) + 4 * tt + (m & 3); const LAS unsigned* sp = ksl + key * 33 + 16 * ks + 4 * g;
              v4u o; o.x = sp[0]; o.y = sp[1]; o.z = sp[2]; o.w = sp[3]; *(v4u*)(Kt + (size_t)c8 * 2048 + pidx * 8) = o; }
            { const int dt = pidx >> 6, d = 16 * dt + m, k0 = 32 * c8 + 8 * g; unsigned w[4];
#pragma unroll
              for (int t = 0; t < 4; ++t) w[t] = (unsigned)vsb[(k0 + 2 * t) * 66 + d] | ((unsigned)vsb[(k0 + 2 * t + 1) * 66 + d] << 16);
              v4u o; o.x = w[0]; o.y = w[1]; o.z = w[2]; o.w = w[3]; *(v4u*)(Vt + (size_t)c8 * 2048 + pidx * 8) = o; } }
    }
    __syncthreads();
    if (tid < 64) { float s = 0.f; for (int q = 0; q < 8; ++q) s += ksum[q * 64 + tid]; ((float*)(p.ws + WS_KMEAN))[(size_t)item * 64 + tid] = s * (1.f / 256.f); }
    if (tid == 0) ((float*)(p.ws + WS_KNMAX))[item] = __uint_as_float(kmx[0]);
    __syncthreads();
}
__device__ __forceinline__ int perm8(int pc, int t) { return 32 * (pc >> 2) + 16 * (t >> 2) + 4 * (pc & 3) + (t & 3); }
__device__ __forceinline__ void gdnprep_item(const Params& p, int l, int ci, LAS unsigned char* lds, int tid_in, int lane_in, int gvar = 0) {
    int tid = tid_in; asm volatile("" : "+v"(tid)); const int lane = tid & 63; (void)lane_in;
    const bf16* U = (const bf16*)(p.ws + WS_U);
    const int bh = ci >> 7, n = ci & 127, b = bh / 6, h = bh % 6;
    LAS float* qs = (LAS float*)lds; LAS float* ks = qs + 4160; LAS float* vs = ks + 4160; LAS float* Lm = vs + 4160; LAS float* Tm = Lm + 4160; LAS float* qk = Tm + 4160; LAS float* us = qk + 4160;
    LAS float* gc = us + 4160; LAS float* bet = gc + 64; LAS float* eg = bet + 64; LAS float* tmpP = eg + 64;
    LAS unsigned char* kb = lds + 120832; LAS unsigned char* qb = lds + 130048; LAS unsigned char* vT = lds + 139264; LAS unsigned char* kT = lds + 148480;
    const int wv = tid >> 6;
    const float* cw = p.in[14] + (size_t)l * 4 * 1152;
    const size_t rbase = (size_t)b * SEQ + n * 64;
    LAS bf16* raw = (LAS bf16*)Lm;
    LAS float* cws = us;
    float ga = 0.f, gb = 0.f, galog = 0.f, gdt = 0.f;
    if (tid < 64) { ga = bf2f(U[(rbase + tid) * DINP + GA0 + h]); gb = bf2f(U[(rbase + tid) * DINP + GB0 + h]); galog = p.in[15][l * 6 + h]; gdt = p.in[16][l * 6 + h]; }
    {   float cwv[2];
#pragma unroll
        for (int i = 0; i < 2; ++i) { const int t = tid + 512 * i; cwv[i] = 0.f; if (t < 768) { const int k = t / 192, cc = t % 192; cwv[i] = cw[k * 1152 + (cc >> 6) * 384 + h * 64 + (cc & 63)]; } }
        v4u rv[4];
#pragma unroll
        for (int i = 0; i < 4; ++i) { const int pi = tid + 512 * i; rv[i] = (v4u){0u, 0u, 0u, 0u};
            if (pi < 1608) { const int r = pi / 24, q = pi % 24, grp = q >> 3, pc = q & 7, tp = n * 64 - 3 + r;
                if (tp >= 0) rv[i] = *(const v4u*)(U + ((size_t)b * SEQ + tp) * DINP + GQ0 + grp * 384 + h * 64 + 8 * pc); } }
#pragma unroll
        for (int i = 0; i < 4; ++i) { const int pi = tid + 512 * i; if (pi < 1608) { const int r = pi / 24, q = pi % 24; *(LAS v4u*)(raw + r * 192 + 8 * q) = rv[i]; } }
#pragma unroll
        for (int i = 0; i < 2; ++i) { const int t = tid + 512 * i; if (t < 768) cws[t] = cwv[i]; }
    }
    __syncthreads();
    {
        const int r = tid >> 3, pt = tid & 7; float o[3][8];
#pragma unroll
        for (int grp = 0; grp < 3; ++grp) {
            const int cc = grp * 64 + pt * 8; float a[8];
#pragma unroll
            for (int t = 0; t < 8; ++t) a[t] = 0.f;
#pragma unroll
            for (int k = 0; k < 4; ++k) { const v4u rw = *(const LAS v4u*)(raw + (r + k) * 192 + cc); const f32x4 c0 = *(const LAS f32x4*)(cws + k * 192 + cc), c1 = *(const LAS f32x4*)(cws + k * 192 + cc + 4);
                a[0] += __uint_as_float(rw.x << 16) * c0[0]; a[1] += __uint_as_float(rw.x & 0xffff0000u) * c0[1]; a[2] += __uint_as_float(rw.y << 16) * c0[2]; a[3] += __uint_as_float(rw.y & 0xffff0000u) * c0[3];
                a[4] += __uint_as_float(rw.z << 16) * c1[0]; a[5] += __uint_as_float(rw.z & 0xffff0000u) * c1[1]; a[6] += __uint_as_float(rw.w << 16) * c1[2]; a[7] += __uint_as_float(rw.w & 0xffff0000u) * c1[3]; }
#pragma unroll
            for (int t = 0; t < 8; ++t) o[grp][t] = silu_f(a[t]);
        }
        if (tid < 64) {
            const float xx = ga + gdt; const float sp = xx > 20.f ? xx : log1pf(expf(xx));
            float g = -expf(galog) * sp;
#pragma unroll
            for (int o2 = 1; o2 < 64; o2 <<= 1) { const float t = __shfl_up(g, o2); if (lane >= o2) g += t; }
            gc[tid] = g; bet[tid] = sigmoid_f(gb); eg[tid] = expf(g);
        }
        float sq = 0.f, sk = 0.f;
#pragma unroll
        for (int t = 0; t < 8; ++t) { sq += o[0][t] * o[0][t]; sk += o[1][t] * o[1][t]; }
        sq += __shfl_xor(sq, 1); sq += __shfl_xor(sq, 2); sq += __shfl_xor(sq, 4); sk += __shfl_xor(sk, 1); sk += __shfl_xor(sk, 2); sk += __shfl_xor(sk, 4);
        const float rq = rsqrtf(sq + EPS) * 0.125f, rk = rsqrtf(sk + EPS);
        float qn[8], kn[8];
#pragma unroll
        for (int t = 0; t < 8; ++t) { qn[t] = o[0][t] * rq; kn[t] = o[1][t] * rk; qs[r * 65 + pt * 8 + t] = qn[t]; ks[r * 65 + pt * 8 + t] = kn[t]; vs[r * 65 + pt * 8 + t] = o[2][t]; }
        v4u w; w.x = pk2(qn[0], qn[1]); w.y = pk2(qn[2], qn[3]); w.z = pk2(qn[4], qn[5]); w.w = pk2(qn[6], qn[7]); *(LAS v4u*)(qb + r * 144 + pt * 16) = w;
        w.x = pk2(kn[0], kn[1]); w.y = pk2(kn[2], kn[3]); w.z = pk2(kn[4], kn[5]); w.w = pk2(kn[6], kn[7]); *(LAS v4u*)(kb + r * 144 + pt * 16) = w;
#pragma unroll
        for (int t = 0; t < 8; ++t) { ((LAS bf16*)kT)[(pt * 8 + t) * 72 + r] = (bf16)(pk2(kn[t], 0.f) & 0xffffu); ((LAS bf16*)vT)[(pt * 8 + t) * 72 + r] = (bf16)(pk2(o[2][t], 0.f) & 0xffffu); }
    }
    if (gvar == 1) { __syncthreads(); return; }
    __syncthreads();
    {   const int kind = wv >> 2, mt = wv & 3, n16 = lane & 15, g4 = lane >> 4;
        const LAS unsigned char* ap = (kind ? qb : kb) + (16 * mt + n16) * 144 + g4 * 16;
        const bf16x8 a0 = *(const LAS bf16x8*)ap, a1 = *(const LAS bf16x8*)(ap + 64);
#pragma unroll
        for (int nt = 0; nt < 4; ++nt) { const LAS unsigned char* bp = kb + (16 * nt + n16) * 144 + g4 * 16;
            f32x4 acc = {0.f, 0.f, 0.f, 0.f}; acc = MFMA16(a0, *(const LAS bf16x8*)bp, acc); acc = MFMA16(a1, *(const LAS bf16x8*)(bp + 64), acc);
            const int sI = 16 * nt + n16; const float gs = gc[sI];
#pragma unroll
            for (int i = 0; i < 4; ++i) { const int c = 16 * mt + 4 * g4 + i; const float dec = (sI <= c) ? expf(gc[c] - gs) : 0.f;
                if (kind == 0) { Lm[c * 65 + sI] = (sI < c) ? bet[c] * acc[i] * dec : 0.f; Tm[c * 65 + sI] = 0.f; } else qk[c * 65 + sI] = acc[i] * dec; } } }
    __syncthreads();
    if (gvar == 2) { __syncthreads(); return; }
    if (tid < 64) { const int blk = tid >> 4, cc = tid & 15; float t[16];
#pragma unroll
        for (int r = 0; r < 16; ++r) { float v = (r == cc) ? 1.f : 0.f;
#pragma unroll
            for (int j = 0; j < 16; ++j) if (j < r) v -= Lm[(16 * blk + r) * 65 + 16 * blk + j] * t[j];
            t[r] = v; }
#pragma unroll
        for (int r = 0; r < 16; ++r) Tm[(16 * blk + r) * 65 + 16 * blk + cc] = t[r]; }
    __syncthreads();
#pragma unroll
    for (int dist = 1; dist < 4; ++dist) { const int np = 4 - dist;
        for (int idx = tid; idx < np * 256; idx += 512) { const int pr = idx >> 8, r = (idx >> 4) & 15, cc = idx & 15, i = pr + dist, j = pr; float a0 = 0.f, a1 = 0.f;
            const LAS float* lp = Lm + (16 * i + r) * 65 + 16 * j; const LAS float* tp = Tm + (16 * j) * 65 + 16 * j + cc;
#pragma unroll 8
            for (int k = 0; k < 16 * dist; k += 2) { a0 += lp[k] * tp[k * 65]; a1 += lp[k + 1] * tp[(k + 1) * 65]; }
            tmpP[pr * 272 + r * 17 + cc] = a0 + a1; }
        __syncthreads();
        for (int idx = tid; idx < np * 256; idx += 512) { const int pr = idx >> 8, r = (idx >> 4) & 15, cc = idx & 15, i = pr + dist, j = pr; float a0 = 0.f, a1 = 0.f;
#pragma unroll
            for (int k = 0; k < 16; k += 2) { a0 += Tm[(16 * i + r) * 65 + 16 * i + k] * tmpP[pr * 272 + k * 17 + cc]; a1 += Tm[(16 * i + r) * 65 + 16 * i + k + 1] * tmpP[pr * 272 + (k + 1) * 17 + cc]; }
            Tm[(16 * i + r) * 65 + 16 * j + cc] = -(a0 + a1); }
        __syncthreads();
    }
    if (gvar == 3) { __syncthreads(); return; }
    {   const int c = tid >> 3, pt = tid & 7; float tb[8], tg[8];
#pragma unroll
        for (int t = 0; t < 8; ++t) { const int sI = pt * 8 + t; tb[t] = Tm[c * 65 + sI] * bet[sI]; tg[t] = tb[t] * eg[sI]; }
        v4u w; w.x = pk2(tb[0], tb[1]); w.y = pk2(tb[2], tb[3]); w.z = pk2(tb[4], tb[5]); w.w = pk2(tb[6], tb[7]); *(LAS v4u*)(kb + c * 144 + pt * 16) = w;
        w.x = pk2(tg[0], tg[1]); w.y = pk2(tg[2], tg[3]); w.z = pk2(tg[4], tg[5]); w.w = pk2(tg[6], tg[7]); *(LAS v4u*)(qb + c * 144 + pt * 16) = w; }
    __syncthreads();
    {   const int kind = wv >> 2, mt = wv & 3, n16 = lane & 15, g4 = lane >> 4;
        const LAS unsigned char* ap = (kind ? qb : kb) + (16 * mt + n16) * 144 + g4 * 16;
        const bf16x8 a0 = *(const LAS bf16x8*)ap, a1 = *(const LAS bf16x8*)(ap + 64);
        LAS float* dst = kind ? Lm : us;
#pragma unroll
        for (int nt = 0; nt < 4; ++nt) { const LAS unsigned char* bp = (kind ? kT : vT) + (16 * nt + n16) * 144 + g4 * 16;
            f32x4 acc = {0.f, 0.f, 0.f, 0.f}; acc = MFMA16(a0, *(const LAS bf16x8*)bp, acc); acc = MFMA16(a1, *(const LAS bf16x8*)(bp + 64), acc);
#pragma unroll
            for (int i = 0; i < 4; ++i) dst[(16 * mt + 4 * g4 + i) * 65 + 16 * nt + n16] = acc[i]; } }
    __syncthreads();
    { const int row = 16 * (tid >> 7) + (tid & 15), pc = 4 * ((tid >> 6) & 1) + ((tid >> 4) & 3); const size_t off = (size_t)ci * 4096 + (size_t)tid * 8;
      float v[8]; v4u o;
      const float egr = eg[row], gl = gc[63];
#pragma unroll
      for (int t = 0; t < 8; ++t) v[t] = Lm[row * 65 + perm8(pc, t)];
      o.x = pk2(v[0], v[1]); o.y = pk2(v[2], v[3]); o.z = pk2(v[4], v[5]); o.w = pk2(v[6], v[7]); *(v4u*)((bf16*)(p.ws + WS_AW) + off) = o;
#pragma unroll
      for (int t = 0; t < 8; ++t) v[t] = qk[row * 65 + perm8(pc, t)];
      o.x = pk2(v[0], v[1]); o.y = pk2(v[2], v[3]); o.z = pk2(v[4], v[5]); o.w = pk2(v[6], v[7]); *(v4u*)((bf16*)(p.ws + WS_AQK) + off) = o;
#pragma unroll
      for (int t = 0; t < 8; ++t) v[t] = qs[row * 65 + perm8(pc, t)] * egr;
      o.x = pk2(v[0], v[1]); o.y = pk2(v[2], v[3]); o.z = pk2(v[4], v[5]); o.w = pk2(v[6], v[7]); *(v4u*)((bf16*)(p.ws + WS_AQD) + off) = o;
#pragma unroll
      for (int t = 0; t < 8; ++t) { const int s = perm8(pc, t); v[t] = ks[s * 65 + row] * expf(gl - gc[s]); }
      o.x = pk2(v[0], v[1]); o.y = pk2(v[2], v[3]); o.z = pk2(v[4], v[5]); o.w = pk2(v[6], v[7]); *(v4u*)((bf16*)(p.ws + WS_AKD) + off) = o;
      const int e0 = 8 * tid, slice = e0 >> 10, mt = (e0 >> 8) & 3;
#pragma unroll
      for (int t = 0; t < 8; ++t) { const int ln = (2 * tid + (t >> 2)) & 63, i = t & 3; v[t] = us[(16 * mt + 4 * (ln >> 4) + i) * 65 + 16 * slice + (ln & 15)]; }
      o.x = pk2(v[0], v[1]); o.y = pk2(v[2], v[3]); o.z = pk2(v[4], v[5]); o.w = pk2(v[6], v[7]); *(v4u*)((bf16*)(p.ws + WS_UD) + (size_t)ci * 4096 + e0) = o;
      if (tid == 0) ((float*)(p.ws + WS_EGL))[ci] = eg[63]; }
    __syncthreads();
}

template <int VAR>
__device__ __forceinline__ void gdn_scan(const Params& p, int l, int bh, LAS unsigned char* lds, int tid, int wave, int lane) {
    constexpr int BUFB = 26624, OFF_U = 18432, OFF_EG = 3 * BUFB;
    LAS float* egls = (LAS float*)(lds + OFF_EG);
    const int ci0 = bh * 128;
    if (wave >= 4) {
        const int t = tid - 256;
        const unsigned char* src[3] = { p.ws + WS_AW, p.ws + WS_AKD, p.ws + WS_UD };
        const float* EGL = (const float*)(p.ws + WS_EGL);
        unsigned ldA[2], ldL[2]; size_t gA[2];
#pragma unroll
        for (int j = 0; j < 2; ++j) { const int q = t + 256 * j; ldA[j] = (16 * (q >> 7) + (q & 15)) * 144 + (4 * ((q >> 6) & 1) + ((q >> 4) & 3)) * 16; ldL[j] = q * 16; gA[j] = (size_t)ci0 * 8192 + q * 16; }
        v4u pf[3][6]; float pe[3] = {0.f, 0.f, 0.f};
#define SC_LOAD(S, M) do { const int mo_ = (M) < 127 ? (M) : 127; \
        _Pragma("unroll") for (int i_ = 0; i_ < 3; ++i_) _Pragma("unroll") for (int j_ = 0; j_ < 2; ++j_) pf[S][2 * i_ + j_] = *(const v4u*)(src[i_] + gA[j_] + (size_t)mo_ * 8192); \
        pe[S] = EGL[ci0 + mo_]; } while (0)
#define SC_STORE(S, BUF) do { LAS unsigned char* d_ = lds + (BUF) * BUFB; \
        _Pragma("unroll") for (int i_ = 0; i_ < 2; ++i_) _Pragma("unroll") for (int j_ = 0; j_ < 2; ++j_) *(LAS v4u*)(d_ + i_ * 9216 + ldA[j_]) = pf[S][2 * i_ + j_]; \
        _Pragma("unroll") for (int j_ = 0; j_ < 2; ++j_) *(LAS v4u*)(d_ + OFF_U + ldL[j_]) = pf[S][4 + j_]; \
        if (t == 0) egls[BUF] = pe[S]; } while (0)
        SC_LOAD(0, 0); SC_LOAD(1, 1); SC_STORE(0, 0); SC_LOAD(2, 2); SC_STORE(1, 1); SC_LOAD(0, 3); SC_LOAD(1, 4);
        __syncthreads();
#define SC_LSTEP(N, SX) do { const int n = (N); if (n < 128) { SC_STORE(SX, SX); SC_LOAD(SX, n + 5); __syncthreads(); } } while (0)
        for (int n0 = 0; n0 < 128; n0 += 3) { SC_LSTEP(n0, 2); SC_LSTEP(n0 + 1, 0); SC_LSTEP(n0 + 2, 1); }
#undef SC_LSTEP
#undef SC_LOAD
#undef SC_STORE
    } else {
        const int n16 = lane & 15, g = lane >> 4;
        unsigned char* SV = p.ws + WS_SV + (size_t)ci0 * 8192 + wave * 2048 + lane * 16;
        f32x4 S[4]; bf16x8 Sb[2];
#pragma unroll
        for (int i = 0; i < 4; ++i) S[i] = (f32x4){0.f, 0.f, 0.f, 0.f};
        Sb[0] = (bf16x8){0, 0, 0, 0, 0, 0, 0, 0}; Sb[1] = Sb[0];
        __syncthreads();
#define AFR(base, mat, mt, ks) (*(const LAS bf16x8*)((base) + (mat) * 9216 + (mt) * (16 * 144) + (ks) * 64))
        bf16x8 fa[4][2]; v2u uw[4]; float egl;
        {   const LAS unsigned char* ab = lds + (n16 * 144) + g * 16;
#pragma unroll
            for (int mt = 0; mt < 4; ++mt) { fa[mt][0] = AFR(ab, 0, mt, 0); fa[mt][1] = AFR(ab, 0, mt, 1); uw[mt] = *(const LAS v2u*)(lds + OFF_U + ((wave * 4 + mt) * 64 + lane) * 8); }
            egl = egls[0]; }
        int cb = 0;
        for (int n = 0; n < 128; ++n) {
            const int nb = (cb == 2) ? 0 : cb + 1;
            const LAS unsigned char* ab = lds + cb * BUFB + (n16 * 144) + g * 16;
            *(bf16x8*)(SV + (size_t)n * 8192) = Sb[0]; *(bf16x8*)(SV + (size_t)n * 8192 + 1024) = Sb[1];
            bf16x8 fb[4][2];
#pragma unroll
            for (int mt = 0; mt < 4; ++mt) { fb[mt][0] = AFR(ab, 1, mt, 0); fb[mt][1] = AFR(ab, 1, mt, 1); }
            f32x4 vn[4];
#pragma unroll
            for (int mt = 0; mt < 4; ++mt) {
                f32x4 uc; uc[0] = __uint_as_float(uw[mt].x << 16); uc[1] = __uint_as_float(uw[mt].x & 0xffff0000u); uc[2] = __uint_as_float(uw[mt].y << 16); uc[3] = __uint_as_float(uw[mt].y & 0xffff0000u);
                f32x4 a = {0.f, 0.f, 0.f, 0.f}; a = MFMA16(fa[mt][0], Sb[0], a); a = MFMA16(fa[mt][1], Sb[1], a); vn[mt] = uc - a; }
            bf16x8 vb[2]; vb[0] = pack8(vn[0], vn[1]); vb[1] = pack8(vn[2], vn[3]);
            const float eg_cur = egl;
            {
                const LAS unsigned char* an = lds + nb * BUFB + (n16 * 144) + g * 16;
#pragma unroll
                for (int mt = 0; mt < 4; ++mt) { fa[mt][0] = AFR(an, 0, mt, 0); fa[mt][1] = AFR(an, 0, mt, 1); uw[mt] = *(const LAS v2u*)(lds + nb * BUFB + OFF_U + ((wave * 4 + mt) * 64 + lane) * 8); }
                egl = egls[nb]; }
#pragma unroll
            for (int mt = 0; mt < 4; ++mt) { f32x4 a = S[mt] * eg_cur; a = MFMA16(fb[mt][0], vb[0], a); a = MFMA16(fb[mt][1], vb[1], a); S[mt] = a; }
            Sb[0] = pack8(S[0], S[1]); Sb[1] = pack8(S[2], S[3]);
            cb = nb;
            __syncthreads();
        }
#undef AFR
    }
    __syncthreads();
}
struct OphRegs { bf16x8 Sb[2], aw[4][2], aq[2][2], ak[2][2]; v2u un[4]; v4u zv; };
__device__ __forceinline__ void gdn_out_load(const Params& p, int ci, OphRegs& R, int tid, int wave, int lane) {
    const bf16* U = (const bf16*)(p.ws + WS_U);
    const int bh = ci >> 7, n = ci & 127, b = bh / 6, h = bh % 6;
    const int sl = wave & 3, hm = wave >> 2, n16 = lane & 15, g = lane >> 4;
    const size_t co = (size_t)ci * 4096;
    const bf16* SV = (const bf16*)(p.ws + WS_SV) + co; const bf16* AW = (const bf16*)(p.ws + WS_AW) + co; const bf16* AQD = (const bf16*)(p.ws + WS_AQD) + co;
    const bf16* AQK = (const bf16*)(p.ws + WS_AQK) + co; const bf16* UD = (const bf16*)(p.ws + WS_UD) + co;
    const int zrow = tid >> 3, zpc = tid & 7; const size_t grow = (size_t)b * SEQ + n * 64 + zrow;
    R.zv = *(const v4u*)(U + grow * DINP + GZ0 + h * 64 + 8 * zpc);
#pragma unroll
    for (int ks = 0; ks < 2; ++ks) R.Sb[ks] = *(const bf16x8*)(SV + ((sl * 2 + ks) * 64 + lane) * 8);
#pragma unroll
    for (int mt = 0; mt < 4; ++mt) { R.un[mt] = *(const v2u*)(UD + ((sl * 4 + mt) * 64 + lane) * 4);
#pragma unroll
        for (int ks = 0; ks < 2; ++ks) R.aw[mt][ks] = *(const bf16x8*)(AW + (((mt * 2 + ks) * 4 + g) * 16 + n16) * 8); }
#pragma unroll
    for (int mi = 0; mi < 2; ++mi)
#pragma unroll
        for (int ks = 0; ks < 2; ++ks) { const int off = ((((2 * hm + mi) * 2 + ks) * 4 + g) * 16 + n16) * 8; R.aq[mi][ks] = *(const bf16x8*)(AQD + off); R.ak[mi][ks] = *(const bf16x8*)(AQK + off); }
}
__device__ __forceinline__ void gdn_out_compute(const Params& p, int l, int ci, const OphRegs& R, LAS unsigned char* lds, int tid, int wave, int lane) {
    bf16* Y = (bf16*)(p.ws + WS_Y);
    const int bh = ci >> 7, n = ci & 127, b = bh / 6, h = bh % 6;
    const int sl = wave & 3, hm = wave >> 2, n16 = lane & 15, g = lane >> 4;
    LAS float* Ot = (LAS float*)lds;
    const int zrow = tid >> 3, zpc = tid & 7; const size_t grow = (size_t)b * SEQ + n * 64 + zrow;
    f32x4 vn[4];
#pragma unroll
    for (int mt = 0; mt < 4; ++mt) { f32x4 uc; uc[0] = __uint_as_float(R.un[mt].x << 16); uc[1] = __uint_as_float(R.un[mt].x & 0xffff0000u); uc[2] = __uint_as_float(R.un[mt].y << 16); uc[3] = __uint_as_float(R.un[mt].y & 0xffff0000u);
        f32x4 a = {0.f, 0.f, 0.f, 0.f}; a = MFMA16(R.aw[mt][0], R.Sb[0], a); a = MFMA16(R.aw[mt][1], R.Sb[1], a); vn[mt] = uc - a; }
    bf16x8 vb[2]; vb[0] = pack8(vn[0], vn[1]); vb[1] = pack8(vn[2], vn[3]);
#pragma unroll
    for (int mi = 0; mi < 2; ++mi) { f32x4 a = {0.f, 0.f, 0.f, 0.f}; a = MFMA16(R.aq[mi][0], R.Sb[0], a); a = MFMA16(R.aq[mi][1], R.Sb[1], a); a = MFMA16(R.ak[mi][0], vb[0], a); a = MFMA16(R.ak[mi][1], vb[1], a);
#pragma unroll
        for (int i = 0; i < 4; ++i) Ot[(16 * (2 * hm + mi) + 4 * g + i) * 65 + 16 * sl + n16] = a[i]; }
    __syncthreads();
    {   float v[8]; float ss = 0.f;
#pragma unroll
        for (int t = 0; t < 8; ++t) { v[t] = Ot[zrow * 65 + 8 * zpc + t]; ss += v[t] * v[t]; }
        ss += __shfl_xor(ss, 1); ss += __shfl_xor(ss, 2); ss += __shfl_xor(ss, 4);
        const float rstd = rsqrtf(ss * (1.f / 64.f) + EPS); const LAS float* ng = Ot + 4160 + 8 * zpc;
        const unsigned zw[4] = {R.zv.x, R.zv.y, R.zv.z, R.zv.w}; v4u o;
        unsigned ow[4];
#pragma unroll
        for (int c = 0; c < 4; ++c) { const float za = __uint_as_float(zw[c] << 16), zb = __uint_as_float(zw[c] & 0xffff0000u);
            ow[c] = pk2(v[2 * c] * rstd * ng[2 * c] * silu_f(za), v[2 * c + 1] * rstd * ng[2 * c + 1] * silu_f(zb)); }
        o.x = ow[0]; o.y = ow[1]; o.z = ow[2]; o.w = ow[3];
        *(v4u*)(Y + grow * DM + 640 + h * 64 + 8 * zpc) = o; }
    __syncthreads();
}
__device__ __forceinline__ void gdn_out_phase(const Params& p, int l, int it0, int step, LAS unsigned char* lds, int tid, int wave, int lane) {
    OphRegs RA, RB;
    if (tid < 64) ((LAS float*)lds)[4160 + tid] = p.in[17][l * 64 + tid];
    if (it0 < 1536) gdn_out_load(p, it0, RA, tid, wave, lane);
    for (int it = it0; it < 1536; it += 2 * step) {
        const int it1 = it + step, it2 = it + 2 * step;
        if (it1 < 1536) gdn_out_load(p, it1, RB, tid, wave, lane);
        gdn_out_compute(p, l, it, RA, lds, tid, wave, lane);
        if (it1 < 1536) {
            if (it2 < 1536) gdn_out_load(p, it2, RA, tid, wave, lane);
            gdn_out_compute(p, l, it1, RB, lds, tid, wave, lane);
        }
    }
}

constexpr float MOBA_C2 = 0.125f * 1.4426950408889634f;
#ifndef MB_NC
#define MB_NC 8
#endif
constexpr int MB_PR = 68;
constexpr int MB_P = 0, MB_LSEL = 104448, MB_MSH = 107520, MB_CNT = 108544, MB_TST = 108672, MB_LIST = 108928, MB_QS = 124800, MB_KMAX = 161664;
template <bool OWN>
__device__ __forceinline__ void moba_task(const bf16* KT, const bf16* VT, bf16* Y, int b, int h, int bh, int qb, int j, int gi, int nv, int nsel, int wave, int lane, LAS unsigned char* lds) {
    int ln_ = lane; asm volatile("" : "+v"(ln_));
    const int n = ln_ & 15, g = ln_ >> 4;
    const LAS float* msh = (const LAS float*)(lds + MB_MSH); LAS float* lsel = (LAS float*)(lds + MB_LSEL); const LAS unsigned short* list = (const LAS unsigned short*)(lds + MB_LIST);
    const LAS unsigned char* Qs = lds + MB_QS;
    int ql[2], sl[2]; bool valid[2]; float msl[2];
#pragma unroll
    for (int nt = 0; nt < 2; ++nt) {
        const int slot = 16 * nt + n;
        if (OWN) { ql[nt] = 32 * wave + slot; sl[nt] = 0; valid[nt] = true; }
        else { valid[nt] = slot < nv; const unsigned e = list[j * 256 + 32 * gi + (valid[nt] ? slot : 0)]; ql[nt] = e & 255; sl[nt] = e >> 8; }
        msl[nt] = msh[ql[nt]];
    }
    const int nch = OWN ? (wave + 1) : 8;
    const bf16* kbase = KT + ((size_t)bh * 256 + j * 8) * 2048 + g * 128 + n * 8;
    const bf16* vbase = VT + ((size_t)bh * 256 + j * 8) * 2048 + g * 128 + n * 8;
    f32x4 O[4][2]; float ls[2] = {0.f, 0.f};
#pragma unroll
    for (int dt = 0; dt < 4; ++dt) { O[dt][0] = (f32x4){0.f, 0.f, 0.f, 0.f}; O[dt][1] = O[dt][0]; }
#pragma unroll 1
    for (int c0 = 0; c0 < nch; c0 += MB_NC) {
        bf16x8 pb[MB_NC][2];
        {   bf16x8 kf[MB_NC][2][2];
#pragma unroll
            for (int cc = 0; cc < MB_NC; ++cc) { const int c_ = (c0 + cc) < nch ? (c0 + cc) : nch - 1;
#pragma unroll
                for (int tt = 0; tt < 2; ++tt) { const bf16* kp_ = kbase + (size_t)c_ * 2048 + tt * 1024; kf[cc][tt][0] = *(const bf16x8*)kp_; kf[cc][tt][1] = *(const bf16x8*)(kp_ + 512); } }
            bf16x8 qf[2][2];
#pragma unroll
            for (int nt = 0; nt < 2; ++nt) { qf[nt][0] = *(const LAS bf16x8*)(Qs + ql[nt] * 144 + g * 16); qf[nt][1] = *(const LAS bf16x8*)(Qs + ql[nt] * 144 + 64 + g * 16); }
#pragma unroll
            for (int cc = 0; cc < MB_NC; ++cc) {
                const int kc = c0 + cc;
#pragma unroll
                for (int nt = 0; nt < 2; ++nt) {
                    f32x4 s[2];
#pragma unroll
                    for (int tt = 0; tt < 2; ++tt) { f32x4 a = {-msl[nt], -msl[nt], -msl[nt], -msl[nt]}; a = MFMA16(kf[cc][tt][0], qf[nt][0], a); a = MFMA16(kf[cc][tt][1], qf[nt][1], a); s[tt] = a; }
#pragma unroll
                    for (int tt = 0; tt < 2; ++tt)
#pragma unroll
                        for (int i = 0; i < 4; ++i) { float pv = __builtin_amdgcn_exp2f(s[tt][i]);
                            if (OWN) { if (32 * kc + 8 * g + 4 * tt + i > ql[nt]) pv = 0.f; }
                            if (OWN) { if (kc >= nch) pv = 0.f; }
                            s[tt][i] = pv; ls[nt] += pv; }
                    pb[cc][nt] = pack8(s[0], s[1]);
                }
            }
        }
        {   bf16x8 vf[MB_NC][4];
#pragma unroll
            for (int cc = 0; cc < MB_NC; ++cc) { const int c_ = (c0 + cc) < nch ? (c0 + cc) : nch - 1;
#pragma unroll
                for (int dt = 0; dt < 4; ++dt) vf[cc][dt] = *(const bf16x8*)(vbase + (size_t)c_ * 2048 + dt * 512); }
#pragma unroll
            for (int cc = 0; cc < MB_NC; ++cc)
#pragma unroll
                for (int dt = 0; dt < 4; ++dt) { O[dt][0] = MFMA16(vf[cc][dt], pb[cc][0], O[dt][0]); O[dt][1] = MFMA16(vf[cc][dt], pb[cc][1], O[dt][1]); }
        }
    }
#pragma unroll
    for (int nt = 0; nt < 2; ++nt) {
        float l = ls[nt]; l += __shfl_xor(l, 16); l += __shfl_xor(l, 32);
        if (OWN) {
            for (int sidx = 0; sidx < nsel; ++sidx) {
                l += lsel[sidx * 256 + ql[nt]];
#pragma unroll
                for (int dt = 0; dt < 4; ++dt) { const v2u w = *(const LAS v2u*)(lds + MB_P + ((sidx * 256 + ql[nt]) * MB_PR + 16 * dt + 4 * g) * 2);
                    O[dt][nt][0] += __uint_as_float(w.x << 16); O[dt][nt][1] += __uint_as_float(w.x & 0xffff0000u); O[dt][nt][2] += __uint_as_float(w.y << 16); O[dt][nt][3] += __uint_as_float(w.y & 0xffff0000u); }
            }
            const float inv = 1.f / l;
            bf16* yp = Y + ((size_t)b * SEQ + qb * 256 + ql[nt]) * DM + 256 + h * 64 + 4 * g;
#pragma unroll
            for (int dt = 0; dt < 4; ++dt) { v2u w; w.x = pk2(O[dt][nt][0] * inv, O[dt][nt][1] * inv); w.y = pk2(O[dt][nt][2] * inv, O[dt][nt][3] * inv); *(v2u*)(yp + 16 * dt) = w; }
        } else if (valid[nt]) {
#pragma unroll
            for (int dt = 0; dt < 4; ++dt) { v2u w; w.x = pk2(O[dt][nt][0], O[dt][nt][1]); w.y = pk2(O[dt][nt][2], O[dt][nt][3]);
                *(LAS v2u*)(lds + MB_P + ((sl[nt] * 256 + ql[nt]) * MB_PR + 16 * dt + 4 * g) * 2) = w; }
            if (g == 0) lsel[sl[nt] * 256 + ql[nt]] = l;
        }
    }
}
__device__ __forceinline__ void moba_unit(const Params& p, int bh, int qb, LAS unsigned char* lds, int tid, int wave, int lane, int mvar = 0) {
    const bf16* U = (const bf16*)(p.ws + WS_U); const bf16* VT = (const bf16*)(p.ws + WS_VT); const bf16* KT = (const bf16*)(p.ws + WS_KT); bf16* Y = (bf16*)(p.ws + WS_Y);
    const int b = bh / 6, h = bh % 6;
    LAS float* msh = (LAS float*)(lds + MB_MSH); LAS float* kms = (LAS float*)(lds + MB_P);
    LAS int* cnt = (LAS int*)(lds + MB_CNT); LAS int* tstart = (LAS int*)(lds + MB_TST); LAS unsigned short* list = (LAS unsigned short*)(lds + MB_LIST); LAS unsigned char* Qs = lds + MB_QS;
    const float* kmean = (const float*)(p.ws + WS_KMEAN) + (size_t)bh * 32 * 64; const float* knmax = (const float*)(p.ws + WS_KNMAX) + bh * 32;
    const size_t qrow0 = (size_t)b * SEQ + qb * 256;
    {   v4u qv4[4];
#pragma unroll
        for (int i = 0; i < 4; ++i) { const int pi = tid + 512 * i; qv4[i] = *(const v4u*)(U + (qrow0 + (pi >> 3)) * DINP + MQ0 + h * 64 + 8 * (pi & 7)); }
        float km4[4];
#pragma unroll
        for (int i = 0; i < 4; ++i) { const int idx = tid + 512 * i; km4[i] = (idx < qb * 64) ? kmean[idx] : 0.f; }
        float kn = (tid < 32 && tid <= qb) ? knmax[tid] : 0.f;
        if (tid < 32) cnt[tid] = 0;
#pragma unroll
        for (int i = 0; i < 4; ++i) { const int idx = tid + 512 * i; if (idx < 31 * 64) kms[idx] = km4[i]; }
#pragma unroll
        for (int i = 0; i < 4; ++i) { const int pi = tid + 512 * i; const unsigned qw[4] = {qv4[i].x, qv4[i].y, qv4[i].z, qv4[i].w}; v4u o;
            unsigned ow[4];
#pragma unroll
            for (int t = 0; t < 4; ++t) ow[t] = pk2(__uint_as_float(qw[t] << 16) * MOBA_C2, __uint_as_float(qw[t] & 0xffff0000u) * MOBA_C2);
            o.x = ow[0]; o.y = ow[1]; o.z = ow[2]; o.w = ow[3]; *(LAS v4u*)(Qs + (pi >> 3) * 144 + (pi & 7) * 16) = o; }
        if (tid < 64) {
#pragma unroll
            for (int o = 1; o < 64; o <<= 1) kn = fmaxf(kn, __shfl_xor(kn, o));
            if (tid == 0) *(LAS float*)(lds + MB_KMAX) = kn; }
    }
    __syncthreads();
    const float kmax = *(const LAS float*)(lds + MB_KMAX);
    {
        const int q = tid >> 1, hf = tid & 1;
        float qv[64]; float qn2 = 0.f;
#pragma unroll
        for (int c8 = 0; c8 < 8; ++c8) { const v4u w = *(const LAS v4u*)(Qs + q * 144 + c8 * 16);
            qv[8 * c8 + 0] = __uint_as_float(w.x << 16); qv[8 * c8 + 1] = __uint_as_float(w.x & 0xffff0000u); qv[8 * c8 + 2] = __uint_as_float(w.y << 16); qv[8 * c8 + 3] = __uint_as_float(w.y & 0xffff0000u);
            qv[8 * c8 + 4] = __uint_as_float(w.z << 16); qv[8 * c8 + 5] = __uint_as_float(w.z & 0xffff0000u); qv[8 * c8 + 6] = __uint_as_float(w.w << 16); qv[8 * c8 + 7] = __uint_as_float(w.w & 0xffff0000u); }
#pragma unroll
        for (int d = 0; d < 64; ++d) qn2 += qv[d] * qv[d];
        float v1 = -INFINITY, v2 = -INFINITY, v3 = -INFINITY; int i1 = -1, i2 = -1, i3 = -1;
        for (int jj = hf; jj < qb; jj += 2) { float sc = 0.f; const LAS f32x4* kr = (const LAS f32x4*)(kms + jj * 64);
#pragma unroll
            for (int d4 = 0; d4 < 16; ++d4) { const f32x4 kv = kr[d4]; sc += (qv[4 * d4] * kv[0] + qv[4 * d4 + 1] * kv[1]) + (qv[4 * d4 + 2] * kv[2] + qv[4 * d4 + 3] * kv[3]); }
            if (sc > v1) { v3 = v2; i3 = i2; v2 = v1; i2 = i1; v1 = sc; i1 = jj; } else if (sc > v2) { v3 = v2; i3 = i2; v2 = sc; i2 = jj; } else if (sc > v3) { v3 = sc; i3 = jj; } }
        float pvv[3]; int pii[3];
        pvv[0] = __shfl_xor(v1, 1); pvv[1] = __shfl_xor(v2, 1); pvv[2] = __shfl_xor(v3, 1); pii[0] = __shfl_xor(i1, 1); pii[1] = __shfl_xor(i2, 1); pii[2] = __shfl_xor(i3, 1);
#pragma unroll
        for (int t = 0; t < 3; ++t) { const float sc = pvv[t]; const int jj = pii[t];
            if (jj >= 0) {
                if (sc > v1 || (sc == v1 && jj < i1)) { v3 = v2; i3 = i2; v2 = v1; i2 = i1; v1 = sc; i1 = jj; }
                else if (sc > v2 || (sc == v2 && jj < i2)) { v3 = v2; i3 = i2; v2 = sc; i2 = jj; }
                else if (sc > v3 || (sc == v3 && jj < i3)) { v3 = sc; i3 = jj; } } }
        if (hf == 0) {
            if (i1 >= 0) { const int pos = __hip_atomic_fetch_add(&cnt[i1], 1, __ATOMIC_RELAXED, __HIP_MEMORY_SCOPE_WORKGROUP); list[i1 * 256 + pos] = (unsigned short)q; }
            if (i2 >= 0) { const int pos = __hip_atomic_fetch_add(&cnt[i2], 1, __ATOMIC_RELAXED, __HIP_MEMORY_SCOPE_WORKGROUP); list[i2 * 256 + pos] = (unsigned short)(q | 256); }
            if (i3 >= 0) { const int pos = __hip_atomic_fetch_add(&cnt[i3], 1, __ATOMIC_RELAXED, __HIP_MEMORY_SCOPE_WORKGROUP); list[i3 * 256 + pos] = (unsigned short)(q | 512); }
            msh[q] = sqrtf(qn2) * kmax;
        }
    }
    __syncthreads();
    LAS unsigned short* ttab = (LAS unsigned short*)tstart;
    if (tid < 64) { const int ng = (tid < qb) ? ((cnt[tid] + 31) >> 5) : 0; int inc = ng;
#pragma unroll
        for (int o = 1; o < 64; o <<= 1) { const int v = __shfl_up(inc, o); if (lane >= o) inc += v; }
        const int st = inc - ng;
        for (int gi = 0; gi < ng; ++gi) ttab[st + gi] = (unsigned short)(tid | (gi << 8));
        if (tid == 63) ttab[127] = (unsigned short)inc; }
    __syncthreads();
    const int ntask = ttab[127];
    for (int t = wave; t < (mvar == 1 ? 0 : ntask); t += 8) {
        const unsigned te = ttab[t]; const int jj = te & 255, gi = te >> 8; int nv = cnt[jj] - 32 * gi; nv = nv > 32 ? 32 : nv;
        moba_task<false>(KT, VT, Y, b, h, bh, qb, jj, gi, nv, 0, wave, lane, lds);
    }
    __syncthreads();
    moba_task<true>(KT, VT, Y, b, h, bh, qb, qb, 0, 32, qb < 3 ? qb : 3, wave, lane, lds);
    __syncthreads();
}

__device__ __forceinline__ void phase_final(const Params& p, int wave, int lane) {
    const int gw = blockIdx.x * 8 + wave, NGW = gridDim.x * 8; const float* rs = (const float*)(p.ws + WS_RS) + 6 * MTOK; const float* fg = p.in[23];
    f32x4 gv[4];
#pragma unroll
    for (int j = 0; j < 4; ++j) gv[j] = *((const f32x4*)fg + lane + 64 * j);
    for (int row0 = gw; row0 < MTOK; row0 += 4 * NGW) {
        f32x4 v[4][4]; float rstd[4];
#pragma unroll
        for (int rr = 0; rr < 4; ++rr) { const int row = (row0 + rr * NGW) < MTOK ? (row0 + rr * NGW) : row0; rstd[rr] = rsqrtf(rs[row] * (1.f / DM) + EPS); const f32x4* o = (const f32x4*)(p.out + (size_t)row * DM) + lane;
#pragma unroll
            for (int j = 0; j < 4; ++j) v[rr][j] = o[64 * j]; }
#pragma unroll
        for (int rr = 0; rr < 4; ++rr) { const int row = row0 + rr * NGW; if (row < MTOK) { f32x4* o = (f32x4*)(p.out + (size_t)row * DM) + lane;
#pragma unroll
            for (int j = 0; j < 4; ++j) o[64 * j] = v[rr][j] * rstd[rr] * gv[j]; } }
    }
}

__global__ void __launch_bounds__(512) fwd(Params p) {
    extern __shared__ __attribute__((aligned(16))) unsigned char lds_raw[];
    LAS unsigned char* lds = (LAS unsigned char*)lds_raw;
    cg::grid_group grid = cg::this_grid();
    const int G = gridDim.x, bx = blockIdx.x;
    if (threadIdx.x < 16) ((volatile LAS unsigned*)(lds + LDS_BARST))[threadIdx.x] = 0u;
    __syncthreads();
    XcdBarrier xbar = xcd_barrier_post((unsigned*)(p.ws + WS_BAR), (volatile LAS unsigned*)(lds + LDS_BARST));
#define GRID_SYNC() do { if (MK_MULTI) {} else if (first_sync) { grid.sync(); first_sync = false; } else xcd_barrier(xbar); } while (0)
    bool first_sync = true;
    bool rep_done = false; (void)rep_done;
#ifdef PROBE_EXTRA_SYNCS
    for (int i = 0; i < PROBE_EXTRA_SYNCS; ++i) GRID_SYNC();
#endif
#ifndef PROBE_SKIP
#define PROBE_SKIP 0
#endif
    for (int ph = p.ph_lo; ph < p.ph_hi; ++ph) {
        if (ph == 11 && G == 256) continue;
        int tid = threadIdx.x; asm volatile("" : "+v"(tid));
        const int lane = tid & 63, wave = __builtin_amdgcn_readfirstlane(tid >> 6);
        unsigned char* ws = p.ws; asm volatile("" : "+s"(ws));
        if (ph == 0) {
#ifndef NO_PRE
 phase_pre(p, tid, wave, lane);
#endif
}
        else if (ph == NPH - 1) phase_final(p, wave, lane);
        else {
            const int l = (ph - 1) / 10, s0_ = (ph - 1) % 10; const int s = s0_ < 6 ? s0_ : (s0_ == 6 ? 99 : s0_ - 1);
            float* rs = (float*)(ws + WS_RS); const float* mod = (const float*)(ws + WS_MOD) + (l * 2) * 9216; const float* bias = (const float*)(ws + WS_BIAS) + l * BIAS_L;
            unsigned char* wb = ws + WS_W;
            if (s == 0) {
#ifndef NO_CVT
 phase_cvt(p, l, lds, wave, lane, 0, (G != 256) ? 5312 : (l == 0 ? 2048 : 0), bx * 8 + wave, G * 8);
#endif
}
            else if (s == 1 || s == 7) {
                pg8::Gemm g{(const bf16*)(ws + WS_XB), (const bf16*)(wb + (s == 1 ? W_1GU : W_2GU)), MTOK, NGU, DM, (size_t)NGU * DM * 2};
                pg8::StaticOrder S; S.init(MTOK, NGU, G, bx);
                EpiGU E{(bf16*)(ws + WS_U), rs + (3 * l + (s == 1 ? 0 : 2)) * MTOK, bias + (s == 1 ? 0 : 2 * NGU + 2 * DINP)};
#ifndef NO_GU
                pg8::gemm_phase<EpiGU, pg8::StaticOrder, true, true>(lds, g, S, E, tid);
                if (s == 1 && G == 256 && bx >= 128) { __syncthreads(); phase_cvt(p, l, lds, wave, lane, l == 0 ? 2048 : 2112, 5312, (bx - 128) * 8 + wave, 128 * 8); }
#endif
            } else if (s == 2 || s == 6 || s == 8) {
                const int K = (s == 6) ? DM : FF;
                pg8::Gemm g{(const bf16*)(ws + (s == 6 ? WS_Y : WS_U)), (const bf16*)(wb + (s == 2 ? W_D1 : (s == 6 ? W_OUT : W_D2))), MTOK, DM, K, 0};
                pg8::StaticOrder S; S.init(MTOK, DM, G, bx);
                EpiRes E{(l == 0 && s == 2) ? p.in[0] : (const float*)p.out, p.out, (bf16*)(ws + WS_XB), rs + (3 * l + (s == 2 ? 1 : (s == 6 ? 2 : 3))) * MTOK, mod + (s == 2 ? 2048 : (s == 6 ? 5120 : 8192)), (s == 6) ? 1.0f : 0.5f};
#ifndef NO_RES
                pg8::gemm_phase<EpiRes, pg8::StaticOrder, true, true>(lds, g, S, E, tid);
#endif
            } else if (s == 3) {
                pg8::Gemm g{(const bf16*)(ws + WS_XB), (const bf16*)(wb + W_IN), MTOK, DINP, DM, (size_t)DINP * DM * 2};
                pg8::StaticOrder S; S.init(MTOK, DINP, G, bx);
                EpiIn E{(bf16*)(ws + WS_U), rs + (3 * l + 1) * MTOK, bias + 2 * NGU, (const float*)(ws + WS_ROPE)};
#ifndef NO_IN
                pg8::gemm_phase<EpiIn, pg8::StaticOrder, true, true>(lds, g, S, E, tid);
                if (l + 1 < 2 && G == 256 && bx >= 64) { __syncthreads(); phase_cvt(p, l + 1, lds, wave, lane, 0, 2112, (bx - 64) * 8 + wave, 192 * 8); }
#endif
            } else if (s == 4) {
#ifndef NO_GPREP
#ifdef PROBE_GPREP_VAR
                if (!rep_done) { for (int it = bx; it < 1536; it += G) gdnprep_item(p, l, it, lds, tid, lane, PROBE_GPREP_VAR); } else
#endif
                if (!(rep_done && (PROBE_SKIP & 1))) for (int it = bx; it < 1536; it += G) gdnprep_item(p, l, it, lds, tid, lane);
#endif
#ifndef NO_MPREP
#ifdef PROBE_GPREP_VAR
                if (rep_done)
#endif
                if (!(rep_done && (PROBE_SKIP & 4))) for (int it = bx; it < 384; it += G) mobaprep_item(p, it, lds, tid);
#endif
            } else if (s == 99) {
                gdn_out_phase(p, l, bx, G, lds, tid, wave, lane);
            } else if (s == 5) {
                int cv0 = 0, cvn = 0, cvs = 1;
                if (bx < 12) {
#ifndef NO_SCAN
#ifdef PROBE_SCAN_VAR
 if (!rep_done) gdn_scan<PROBE_SCAN_VAR>(p, l, bx, lds, tid, wave, lane); else
#endif
#ifdef PROBE_MOBA_VAR
 if (rep_done)
#endif
 if (!(rep_done && (PROBE_SKIP & 8))) gdn_scan<0>(p, l, bx, lds, tid, wave, lane);
#endif
}
                else if (G == 256) {
                    const int x = bx & 7, first = (x < 4) ? x + 16 : x + 8, nblk = (256 - first + 7) >> 3, lidx = (bx - first) >> 3;
                    unsigned ulist = 0u; int nu = 0;
                    if (lidx < 32) { ulist |= (unsigned)(x * 32 + 31 - lidx) << (10 * nu); ++nu; }
                    { const int i = nblk - 1 - lidx; if (i >= 0 && i < 16) { ulist |= (unsigned)((8 + (x >> 1)) * 32 + 31 - 2 * i - (x & 1)) << (10 * nu); ++nu; } }
                    { const int k = nblk + (nblk - 17 - lidx); if (lidx <= nblk - 17 && k >= nblk && k < 32) { ulist |= (unsigned)(x * 32 + 31 - k) << (10 * nu); ++nu; } }
                    ulist = __builtin_amdgcn_readfirstlane(ulist); nu = __builtin_amdgcn_readfirstlane(nu);
                    for (int ui = 0; ui < nu; ++ui) {
                        const int uu = (ulist >> (10 * ui)) & 1023, cbh = uu >> 5, cqb = uu & 31;
#ifndef NO_MOBA
#ifdef PROBE_MOBA_VAR
                        if (!rep_done) moba_unit(p, cbh, cqb, lds, tid, wave, lane, PROBE_MOBA_VAR); else
#endif
                        if (!(rep_done && (PROBE_SKIP & 16))) moba_unit(p, cbh, cqb, lds, tid, wave, lane);
#endif
                    }
                    {   const int ns = nblk - 18;
                        if (lidx < ns) { cv0 = 32 * x + 2 * lidx; cvn = 2; }
                        else { const int r = 2 * ns + (lidx - (nblk - 16)); if (lidx >= nblk - 16 && r < 32) { cv0 = 32 * x + r; cvn = 1; } } }
                } else { for (int it = bx - 12; it < 384; it += G - 12) moba_unit(p, it % 12, 31 - it / 12, lds, tid, wave, lane);
                    cv0 = bx - 12; cvs = G - 12; cvn = (cv0 < 256) ? (256 - cv0 + cvs - 1) / cvs : 0; }
                for (int k = 0; k < cvn; ++k) conv_item(p, l, cv0 + k * cvs, (LAS float*)lds, tid, wave, lane);
            }
        }
#if defined(PROBE_REP_S)
        if (ph > 0 && ph < NPH - 1 && (ph - 1) % 10 == PROBE_REP_S && !rep_done) { rep_done = true; GRID_SYNC(); --ph; continue; }
        rep_done = false;
#endif
        if (ph + 1 < p.ph_hi) GRID_SYNC();
    }
}

extern "C" void kernel_launch(void* const* d_in, const int* in_sizes, int n_in, void* d_out, int out_size, void* d_ws, size_t ws_size, hipStream_t stream) {
    static int grid = 0;
    if (grid == 0) {
        if (n_in != 24 || out_size != MTOK * DM || ws_size < WS_END) { fprintf(stderr, "kernel_launch: unexpected shapes (n_in %d out %d ws %zu)\n", n_in, out_size, ws_size); grid = -1; return; }
        int dev = 0, cus = 0, per_cu = 0;
        hipGetDevice(&dev); hipDeviceGetAttribute(&cus, hipDeviceAttributeMultiprocessorCount, dev);
        hipFuncSetAttribute((const void*)fwd, hipFuncAttributeMaxDynamicSharedMemorySize, LDS_BYTES);
        hipOccupancyMaxActiveBlocksPerMultiprocessor(&per_cu, (const void*)fwd, 512, LDS_BYTES);
        if (per_cu < 1) per_cu = 1;
        grid = cus * per_cu; if (grid > 256) grid = 256;
        (void)hipGetLastError();
    }
    if (grid < 0) return;
    hipMemsetAsync(d_ws, 0, CTL_ZERO, stream);
    Params p{};
    for (int i = 0; i < 24; ++i) p.in[i] = (const float*)d_in[i];
    p.out = (float*)d_out; p.ws = (unsigned char*)d_ws;
#if MK_MULTI
    for (int ph = 0; ph < NPH; ++ph) { p.ph_lo = ph; p.ph_hi = ph + 1; hipLaunchKernelGGL(fwd, dim3(grid), dim3(512), LDS_BYTES, stream, p); }
#else
    p.ph_lo = 0; p.ph_hi = NPH;
    void* args[] = {&p};
    hipError_t e = hipLaunchCooperativeKernel((const void*)fwd, dim3(grid), dim3(512), args, LDS_BYTES, stream);
    if (e != hipSuccess) fprintf(stderr, "cooperative launch failed: %s (grid %d)\n", hipGetErrorString(e), grid);
#endif
}
```
